# Optimizing an MI355X kernel written in HIP

```python
import jax, jax.numpy as jnp
from jax import lax
import numpy as np

D_MODEL = 1024
BATCH = 8
SEQ = 2048
DEPTH = 4

MEM_LEN = 256
D_FF = ((8 * D_MODEL // 3 + 255) // 256) * 256
D_MIX = D_MODEL
W_A = 3 * D_MIX // 8
W_B = 3 * D_MIX // 8
W_C = D_MIX - W_A - W_B
RG_BLOCK = 64
RG_HEADS = W_A // RG_BLOCK
RG_CONV_K = 4
RG_C = 8.0
GLA_HEADS = 4
GLA_DV = W_B // GLA_HEADS
GLA_DK = GLA_DV // 2
GLA_RANK = 16
GLA_TAU = 16.0
GLA_CHUNK = 64
CONV_K = 31
CONV_GROUPS = 4
XA_HEADS = 4
XA_HEAD_DIM = D_MODEL // XA_HEADS
ALPHA = (2.0 * DEPTH) ** 0.25
BETA = (8.0 * DEPTH) ** -0.25
EPS = 1e-5
SPLIT_SIZES = (W_A, W_A, GLA_HEADS * GLA_DK, GLA_HEADS * GLA_DK, W_B, W_B, GLA_RANK, 2 * W_C)
N_IN_COLS = 2 * W_A + 2 * GLA_HEADS * GLA_DK + 2 * W_B + GLA_RANK + 2 * W_C

kernel_name = "hybrid_rglru_gla_conformer_deepnorm"


def layer_norm(x, g, b):
    xf = x.astype(jnp.float32)
    mu = jnp.mean(xf, axis=-1, keepdims=True)
    var = jnp.mean(jnp.square(xf - mu), axis=-1, keepdims=True)
    y = (xf - mu) * lax.rsqrt(var + EPS)
    return (y * g + b).astype(x.dtype)


def swiglu(x, w_in, w_out):
    gate, up = jnp.split(x @ w_in, 2, axis=-1)
    return (jax.nn.silu(gate) * up) @ w_out


def causal_dwconv(x, w, b):
    k, c = w.shape
    y = lax.conv_general_dilated(x, w[:, None, :].astype(x.dtype), window_strides=(1,),
                                 padding=[(k - 1, 0)],
                                 dimension_numbers=("NWC", "WIO", "NWC"),
                                 feature_group_count=c)
    return y + b


def split_cols(h):
    idx = []
    acc = 0
    for s in SPLIT_SIZES[:-1]:
        acc += s
        idx.append(acc)
    return jnp.split(h, idx, axis=-1)


def _lin_combine(left, right):
    a1, b1 = left
    a2, b2 = right
    return a1 * a2, a2 * b1 + b2


def rglru_group(xa, ya, conv_w, conv_b, w_r, b_r, w_i, b_i, lam):
    bsz, s, w = xa.shape
    xc = causal_dwconv(xa, conv_w, conv_b)
    xh = xc.reshape(bsz, s, RG_HEADS, RG_BLOCK)
    r = jax.nn.sigmoid(jnp.einsum("bshi,hij->bshj", xh, w_r).reshape(bsz, s, w) + b_r)
    i = jax.nn.sigmoid(jnp.einsum("bshi,hij->bshj", xh, w_i).reshape(bsz, s, w) + b_i)
    log_a = -RG_C * r.astype(jnp.float32) * jax.nn.softplus(-lam.astype(jnp.float32))
    a = jnp.exp(log_a)
    u = jnp.sqrt(-jnp.expm1(2.0 * log_a)) * (i * xc).astype(jnp.float32)
    _, h = lax.associative_scan(_lin_combine, (a, u), axis=1)
    return (h * jax.nn.gelu(ya.astype(jnp.float32))).astype(xa.dtype)


def gla_chunked(q, k, v, log_alpha):
    bsz, s, h, dk = q.shape
    dv = v.shape[-1]
    n = s // GLA_CHUNK
    q = (q * (dk ** -0.5)).reshape(bsz, n, GLA_CHUNK, h, dk)
    k = k.reshape(bsz, n, GLA_CHUNK, h, dk)
    v = v.reshape(bsz, n, GLA_CHUNK, h, dv)
    bcum = jnp.cumsum(log_alpha.reshape(bsz, n, GLA_CHUNK, h, dk), axis=2)
    b_last = bcum[:, :, -1:]
    q_dec = q * jnp.exp(bcum)
    k_inv = k * jnp.exp(-bcum)
    scores = jnp.einsum("bnihd,bnjhd->bnhij", q_dec, k_inv)
    causal = jnp.tril(jnp.ones((GLA_CHUNK, GLA_CHUNK), dtype=bool))
    scores = jnp.where(causal, scores, 0.0)
    o_intra = jnp.einsum("bnhij,bnjhe->bnihe", scores, v)
    k_tail = k * jnp.exp(b_last - bcum)
    u = jnp.einsum("bnchd,bnche->bnhde", k_tail, v)
    decay = jnp.exp(b_last[:, :, 0])

    def step(state, inp):
        dec, inc = inp
        return dec[..., None] * state + inc, state

    init = jnp.zeros((bsz, h, dk, dv), jnp.float32)
    _, s_prev = lax.scan(step, init, (jnp.moveaxis(decay, 1, 0), jnp.moveaxis(u, 1, 0)))
    s_prev = jnp.moveaxis(s_prev, 0, 1)
    o_inter = jnp.einsum("bnihd,bnhde->bnihe", q_dec, s_prev)
    return (o_intra + o_inter).reshape(bsz, s, h, dv)


def gla_group(q, k, v, g, lr, w_gate, b_gate, norm_g):
    bsz, s, _ = q.shape
    f32 = jnp.float32
    gate_pre = (lr @ w_gate + b_gate).astype(f32)
    log_alpha = (jax.nn.log_sigmoid(gate_pre) / GLA_TAU).reshape(bsz, s, GLA_HEADS, GLA_DK)
    o = gla_chunked(q.astype(f32).reshape(bsz, s, GLA_HEADS, GLA_DK),
                    k.astype(f32).reshape(bsz, s, GLA_HEADS, GLA_DK),
                    v.astype(f32).reshape(bsz, s, GLA_HEADS, GLA_DV), log_alpha)
    o = o * lax.rsqrt(jnp.mean(jnp.square(o), axis=-1, keepdims=True) + EPS) * norm_g
    o = o.reshape(bsz, s, W_B) * jax.nn.silu(g.astype(f32))
    return o.astype(q.dtype)


def conformer_conv_group(c, dw_w, dw_b, gn_g, gn_b):
    bsz, s, _ = c.shape
    a, gate = jnp.split(c, 2, axis=-1)
    u = causal_dwconv(a * jax.nn.sigmoid(gate), dw_w, dw_b)
    uf = u.astype(jnp.float32).reshape(bsz, s, CONV_GROUPS, W_C // CONV_GROUPS)
    mu = jnp.mean(uf, axis=-1, keepdims=True)
    var = jnp.mean(jnp.square(uf - mu), axis=-1, keepdims=True)
    un = ((uf - mu) * lax.rsqrt(var + EPS)).reshape(bsz, s, W_C) * gn_g + gn_b
    return jax.nn.silu(un).astype(c.dtype)


def hybrid_mixer(x, w_in, rg_conv_w, rg_conv_b, rg_w_r, rg_b_r, rg_w_i, rg_b_i, rg_lambda,
                 gla_w_gate, gla_b_gate, gla_norm_g, cv_dw_w, cv_dw_b, cv_gn_g, cv_gn_b, w_out):
    xa, ya, q, k, v, g, lr, c = split_cols(x @ w_in)
    out_a = rglru_group(xa, ya, rg_conv_w, rg_conv_b, rg_w_r, rg_b_r, rg_w_i, rg_b_i, rg_lambda)
    out_b = gla_group(q, k, v, g, lr, gla_w_gate, gla_b_gate, gla_norm_g)
    out_c = conformer_conv_group(c, cv_dw_w, cv_dw_b, cv_gn_g, cv_gn_b)
    return jnp.concatenate([out_a, out_b, out_c], axis=-1) @ w_out


def memory_cross_attn(x, mem, w_q, w_kv, w_o):
    bsz, s, _ = x.shape
    m = mem.shape[1]
    q = (x @ w_q).reshape(bsz, s, XA_HEADS, XA_HEAD_DIM)
    k, v = jnp.split(mem @ w_kv, 2, axis=-1)
    k = k.reshape(bsz, m, XA_HEADS, XA_HEAD_DIM)
    v = v.reshape(bsz, m, XA_HEADS, XA_HEAD_DIM)
    scores = jnp.einsum("bshd,bmhd->bhsm", q, k).astype(jnp.float32) * (XA_HEAD_DIM ** -0.5)
    p = jax.nn.softmax(scores, axis=-1).astype(x.dtype)
    o = jnp.einsum("bhsm,bmhd->bshd", p, v).reshape(bsz, s, D_MODEL)
    return o @ w_o


def setup_inputs(seed: int = 0) -> dict:
    key = jax.random.key(seed)
    ks = iter(jax.random.split(key, 64))

    def nrm(shape, scale):
        return jax.random.normal(next(ks), shape, jnp.float32) * scale

    def gain(shape):
        return 1.0 + nrm(shape, 0.02)

    L = DEPTH
    u = jax.random.uniform(next(ks), (L, W_A), jnp.float32, minval=0.9, maxval=0.999)
    s_a = u ** (1.0 / RG_C)
    rg_lambda = jnp.log(s_a) - jnp.log1p(-s_a)
    xa_w_kv = jnp.concatenate([nrm((L, D_MODEL, D_MODEL), D_MODEL ** -0.5),
                               nrm((L, D_MODEL, D_MODEL), BETA * D_MODEL ** -0.5)], axis=-1)
    return {
        "x": nrm((BATCH, SEQ, D_MODEL), 1.0),
        "mem": nrm((BATCH, MEM_LEN, D_MODEL), 1.0),
        "ffn1_w_in": nrm((L, D_MODEL, 2 * D_FF), D_MODEL ** -0.5),
        "ffn1_w_out": nrm((L, D_FF, D_MODEL), BETA * D_FF ** -0.5),
        "ln1_g": gain((L, D_MODEL)),
        "ln1_b": nrm((L, D_MODEL), 0.02),
        "mix_w_in": nrm((L, D_MODEL, N_IN_COLS), D_MODEL ** -0.5),
        "rg_conv_w": nrm((L, RG_CONV_K, W_A), RG_CONV_K ** -0.5),
        "rg_conv_b": nrm((L, W_A), 0.01),
        "rg_w_r": nrm((L, RG_HEADS, RG_BLOCK, RG_BLOCK), RG_BLOCK ** -0.5),
        "rg_b_r": nrm((L, W_A), 0.01),
        "rg_w_i": nrm((L, RG_HEADS, RG_BLOCK, RG_BLOCK), RG_BLOCK ** -0.5),
        "rg_b_i": nrm((L, W_A), 0.01),
        "rg_lambda": rg_lambda,
        "gla_w_gate": nrm((L, GLA_RANK, GLA_HEADS * GLA_DK), GLA_RANK ** -0.5),
        "gla_b_gate": nrm((L, GLA_HEADS * GLA_DK), 0.01),
        "gla_norm_g": gain((L, GLA_DV)),
        "cv_dw_w": nrm((L, CONV_K, W_C), CONV_K ** -0.5),
        "cv_dw_b": nrm((L, W_C), 0.01),
        "cv_gn_g": gain((L, W_C)),
        "cv_gn_b": nrm((L, W_C), 0.02),
        "mix_w_out": nrm((L, D_MIX, D_MODEL), BETA * D_MIX ** -0.5),
        "ln2_g": gain((L, D_MODEL)),
        "ln2_b": nrm((L, D_MODEL), 0.02),
        "xa_w_q": nrm((L, D_MODEL, D_MODEL), D_MODEL ** -0.5),
        "xa_w_kv": xa_w_kv,
        "xa_w_o": nrm((L, D_MODEL, D_MODEL), BETA * D_MODEL ** -0.5),
        "ln3_g": gain((L, D_MODEL)),
        "ln3_b": nrm((L, D_MODEL), 0.02),
        "ffn2_w_in": nrm((L, D_MODEL, 2 * D_FF), D_MODEL ** -0.5),
        "ffn2_w_out": nrm((L, D_FF, D_MODEL), BETA * D_FF ** -0.5),
        "ln4_g": gain((L, D_MODEL)),
        "ln4_b": nrm((L, D_MODEL), 0.02),
    }


def reference(x, mem, ffn1_w_in, ffn1_w_out, ln1_g, ln1_b, mix_w_in, rg_conv_w, rg_conv_b,
              rg_w_r, rg_b_r, rg_w_i, rg_b_i, rg_lambda, gla_w_gate, gla_b_gate, gla_norm_g,
              cv_dw_w, cv_dw_b, cv_gn_g, cv_gn_b, mix_w_out, ln2_g, ln2_b, xa_w_q, xa_w_kv,
              xa_w_o, ln3_g, ln3_b, ffn2_w_in, ffn2_w_out, ln4_g, ln4_b):
    for l in range(DEPTH):
        x = layer_norm(ALPHA * x + 0.5 * swiglu(x, ffn1_w_in[l], ffn1_w_out[l]), ln1_g[l], ln1_b[l])
        mix = hybrid_mixer(x, mix_w_in[l], rg_conv_w[l], rg_conv_b[l], rg_w_r[l], rg_b_r[l],
                           rg_w_i[l], rg_b_i[l], rg_lambda[l], gla_w_gate[l], gla_b_gate[l],
                           gla_norm_g[l], cv_dw_w[l], cv_dw_b[l], cv_gn_g[l], cv_gn_b[l],
                           mix_w_out[l])
        x = layer_norm(ALPHA * x + mix, ln2_g[l], ln2_b[l])
        x = layer_norm(ALPHA * x + memory_cross_attn(x, mem, xa_w_q[l], xa_w_kv[l], xa_w_o[l]),
                       ln3_g[l], ln3_b[l])
        x = layer_norm(ALPHA * x + 0.5 * swiglu(x, ffn2_w_in[l], ffn2_w_out[l]), ln4_g[l], ln4_b[l])
    return x
```

```cpp
#include <hip/hip_runtime.h>
#include <hip/hip_cooperative_groups.h>
#include <cstdio>
#include <cstdint>
namespace cg = cooperative_groups;

#define LAS __attribute__((address_space(3)))
typedef unsigned short bf16_t;
typedef short bf16x8 __attribute__((ext_vector_type(8)));
typedef float f32x4 __attribute__((ext_vector_type(4)));
typedef unsigned u32x4 __attribute__((ext_vector_type(4)));
typedef unsigned u32x2 __attribute__((ext_vector_type(2)));

constexpr int NB = 8, SEQ = 2048, MTOK = NB * SEQ, D = 1024, FF = 2816, NIN = 2448, NINP = 2560, DEPTH = 4, MEML = 256, MMEM = NB * MEML;
constexpr int WA = 384, WCV = 256;
constexpr float ALPHA = 1.6817928305074290f;
constexpr float EPS = 1e-5f;
constexpr int C_XA = 0, C_YA = 384, C_Q = 768, C_K = 960, C_V = 1152, C_G = 1536, C_LR = 1920, C_CA = 1936, C_CG = 2192;
constexpr int NTHREADS = 512;
constexpr int LDS_BYTES = 144 * 1024;

constexpr size_t al256(size_t x) { return (x + 255) & ~(size_t)255; }
constexpr size_t WS_W1T_A = 0;
constexpr size_t WS_W2T_A = WS_W1T_A + al256((size_t)2 * FF * D * 2);
constexpr size_t WS_W1T_B = WS_W2T_A + al256((size_t)D * FF * 2);
constexpr size_t WS_W2T_B = WS_W1T_B + al256((size_t)2 * FF * D * 2);
constexpr size_t WS_WINT = WS_W2T_B + al256((size_t)D * FF * 2);
constexpr size_t WS_WOUTT = WS_WINT + al256((size_t)NINP * D * 2);
constexpr size_t WS_WQT = WS_WOUTT + al256((size_t)D * D * 2);
constexpr size_t WS_WOT = WS_WQT + al256((size_t)D * D * 2);
constexpr size_t WS_WKVT = WS_WOT + al256((size_t)D * D * 2);
constexpr size_t WS_XN = WS_WKVT + al256((size_t)2 * D * D * 2);
constexpr size_t WS_Y = WS_XN + al256((size_t)MTOK * D * 2);
constexpr size_t WS_R1 = WS_Y + al256((size_t)MTOK * D * 4);
constexpr size_t WS_CAT = WS_R1 + al256((size_t)MTOK * FF * 2);
constexpr size_t WS_MEMB = WS_CAT + al256((size_t)MTOK * D * 2);
constexpr size_t WS_KM = WS_MEMB + al256((size_t)MMEM * D * 2);
constexpr size_t WS_VT = WS_KM + al256((size_t)MMEM * D * 2);
constexpr size_t WS_STATS = WS_VT + al256((size_t)MMEM * D * 2);
constexpr size_t WS_PSUM = WS_STATS + al256((size_t)MTOK * 2 * 4);
constexpr size_t WS_HLOC = WS_PSUM + al256((size_t)NB * 4 * SEQ * 4 * 4);
constexpr size_t WS_ACUM = WS_HLOC + al256((size_t)MTOK * WA * 4);
constexpr size_t WS_AEND = WS_ACUM + al256((size_t)MTOK * WA * 4);
constexpr size_t WS_HEND = WS_AEND + al256((size_t)NB * 32 * WA * 4);
constexpr size_t WS_CIN = WS_HEND + al256((size_t)NB * 32 * WA * 4);
constexpr size_t WS_U = WS_CIN + al256((size_t)NB * 32 * WA * 4);
constexpr size_t WS_DEC = WS_U + al256((size_t)NB * 32 * 4 * 4608 * 4);
constexpr size_t WS_END = WS_DEC + al256((size_t)NB * 32 * 4 * 48 * 4);
constexpr size_t R1_P_OFF = (size_t)MTOK * D * 2;

__device__ __forceinline__ float bf2f(bf16_t v) { return __uint_as_float(((unsigned)v) << 16); }
__device__ __forceinline__ unsigned f2bf(float f) { unsigned u = __float_as_uint(f); return (u + 0x7fffu + ((u >> 16) & 1u)) >> 16; }
__device__ __forceinline__ unsigned pk2(float lo, float hi) { return f2bf(lo) | (f2bf(hi) << 16); }
__device__ __forceinline__ float sigmoidf_(float x) { return 1.0f / (1.0f + __expf(-x)); }
__device__ __forceinline__ float siluf_(float x) { return x / (1.0f + __expf(-x)); }
__device__ __forceinline__ float gelu_tanh(float x) { const float u = 0.7978845608028654f * (x + 0.044715f * x * x * x); return 0.5f * x * (1.0f + tanhf(u)); }
__device__ __forceinline__ float wave_sum(float v) {
#pragma unroll
    for (int o = 1; o < 64; o <<= 1) v += __shfl_xor(v, o);
    return v;
}
#define LDS_WAIT() asm volatile("s_waitcnt lgkmcnt(0)" ::: "memory")
__device__ __forceinline__ int otid() { int t = threadIdx.x; asm volatile("" : "+v"(t)); return t; }

constexpr int BM = 256, BK = 64, HALF = 128, HTB = HALF * BK * 2, NXCD = 8, WGM = 8;
__device__ __forceinline__ int lds_byte(int r, int c) { const int st = (r >> 4) * 2 + (c >> 5), rr = r & 15, cc = c & 31, ob = rr * 64 + cc * 2; return st * 1024 + (ob ^ (((ob >> 9) & 1) << 5)); }
__device__ __forceinline__ void stage_rc(int b, int& R, int& C) { const int st = b / 1024, sb = b % 1024, swz = sb ^ (((sb >> 9) & 1) << 5); R = (st >> 1) * 16 + swz / 64; C = (st & 1) * 32 + (swz % 64) / 2; }
__device__ __forceinline__ int perm32(int rho) { const int n = rho >> 4, i = rho & 15; return 8 * (i >> 2) + 4 * n + (i & 3); }

struct Unit { int pm, pn; };

struct StdProb {
    const bf16_t* A; const bf16_t* Bt; int lda, ldb, K;
    int nM, nN, nwg, G, c;
    __device__ __forceinline__ void init(const bf16_t* A_, const bf16_t* Bt_, int lda_, int ldb_, int K_, int M_, int N_, int G_, int c_) {
        A = A_; Bt = Bt_; lda = lda_; ldb = ldb_; K = K_; nM = M_ / BM; nN = N_ / BM; nwg = nM * nN; G = G_; c = c_; }
    __device__ __forceinline__ bool next(int i, Unit& u) const {
        const long L = (long)i * G + c; if (L >= nwg) return false;
        int wgid = (int)L; { const int q = nwg / NXCD, r = nwg % NXCD, xcd = wgid % NXCD, off = wgid / NXCD; wgid = (xcd < r ? xcd * (q + 1) : r * (q + 1) + (xcd - r) * q) + off; }
        const int nig = WGM * nN, gid = wgid / nig, fm = gid * WGM, gsz = (nM - fm) < WGM ? (nM - fm) : WGM;
        u.pm = fm + ((wgid % nig) % gsz); u.pn = (wgid % nig) / gsz; return true;
    }
    __device__ __forceinline__ const char* aptr(const Unit& u) const { return (const char*)(A + (size_t)u.pm * BM * lda); }
    __device__ __forceinline__ const char* bptr(const Unit& u) const { return (const char*)(Bt + (size_t)u.pn * BM * ldb); }
};
struct ScoreProb {
    const bf16_t* Q; const bf16_t* Km; int lda, ldb, K; int G, c;
    __device__ __forceinline__ bool next(int i, Unit& u) const { const long L = (long)i * G + c; if (L >= 256) return false; u.pm = (int)L; u.pn = 0; return true; }
    __device__ __forceinline__ const char* aptr(const Unit& u) const { const int b = u.pm >> 5, h = (u.pm >> 3) & 3, mt = u.pm & 7; return (const char*)(Q + ((size_t)(b * SEQ + mt * 256) * D + h * 256)); }
    __device__ __forceinline__ const char* bptr(const Unit& u) const { const int b = u.pm >> 5, h = (u.pm >> 3) & 3; return (const char*)(Km + ((size_t)(b * MEML) * D + h * 256)); }
};
struct PVProb {
    const bf16_t* P; const bf16_t* VT; int lda, ldb, K; int G, c;
    __device__ __forceinline__ bool next(int i, Unit& u) const { const long L = (long)i * G + c; if (L >= 256) return false; u.pm = (int)L; u.pn = 0; return true; }
    __device__ __forceinline__ const char* aptr(const Unit& u) const { return (const char*)(P + (size_t)u.pm * 256 * 256); }
    __device__ __forceinline__ const char* bptr(const Unit& u) const { const int b = u.pm >> 5, h = (u.pm >> 3) & 3; return (const char*)(VT + ((size_t)(h * 256) * MMEM + b * MEML)); }
};

struct EpiSwiGLU {
    static constexpr bool PERM = true;
    bf16_t* H;
    __device__ __forceinline__ void operator()(const f32x4 (&acc)[2][2][4][2], const Unit& u, int wr, int wc, int fr, int fq) const {
        const int row0 = u.pm * BM + wr * 64 + fr, col0 = u.pn * 128 + wc * 32 + 8 * fq;
#pragma unroll
        for (int ai = 0; ai < 2; ++ai)
#pragma unroll
            for (int m = 0; m < 4; ++m) {
                bf16_t* rowp = H + (size_t)(row0 + ai * HALF + m * 16) * FF + col0;
                const f32x4 g0 = acc[ai][0][m][0], g1 = acc[ai][0][m][1], u0 = acc[ai][1][m][0], u1 = acc[ai][1][m][1];
                u32x4 w;
                w.x = pk2(siluf_(g0[0]) * u0[0], siluf_(g0[1]) * u0[1]); w.y = pk2(siluf_(g0[2]) * u0[2], siluf_(g0[3]) * u0[3]);
                w.z = pk2(siluf_(g1[0]) * u1[0], siluf_(g1[1]) * u1[1]); w.w = pk2(siluf_(g1[2]) * u1[2], siluf_(g1[3]) * u1[3]);
                *(u32x4*)rowp = w;
            }
    }
};
struct EpiBf16 {
    static constexpr bool PERM = true;
    bf16_t* O; int ldc; float scale;
    __device__ __forceinline__ void operator()(const f32x4 (&acc)[2][2][4][2], const Unit& u, int wr, int wc, int fr, int fq) const {
        const int row0 = u.pm * BM + wr * 64 + fr, col0 = u.pn * BM + wc * 32 + 8 * fq;
#pragma unroll
        for (int ai = 0; ai < 2; ++ai)
#pragma unroll
            for (int m = 0; m < 4; ++m) {
                bf16_t* rowp = O + (size_t)(row0 + ai * HALF + m * 16) * ldc + col0;
#pragma unroll
                for (int bj = 0; bj < 2; ++bj) {
                    const f32x4 v0 = acc[ai][bj][m][0] * scale, v1 = acc[ai][bj][m][1] * scale;
                    u32x4 w; w.x = pk2(v0[0], v0[1]); w.y = pk2(v0[2], v0[3]); w.z = pk2(v1[0], v1[1]); w.w = pk2(v1[2], v1[3]);
                    *(u32x4*)(rowp + bj * HALF) = w;
                }
            }
    }
};
struct EpiRes {
    static constexpr bool PERM = false;
    float* Y; const float* Xin; const float* stats; const float* g; const float* b; float scale;
    __device__ __forceinline__ void operator()(const f32x4 (&acc)[2][2][4][2], const Unit& u, int wr, int wc, int fr, int fq) const {
        const int row0 = u.pm * BM + wr * 64 + fr, col0 = u.pn * BM + wc * 32 + 4 * fq;
        f32x4 gv[2][2], bv[2][2];
#pragma unroll
        for (int bj = 0; bj < 2; ++bj)
#pragma unroll
            for (int n = 0; n < 2; ++n) { gv[bj][n] = *(const f32x4*)(g + col0 + bj * HALF + n * 16); bv[bj][n] = *(const f32x4*)(b + col0 + bj * HALF + n * 16); }
#pragma unroll
        for (int ai = 0; ai < 2; ++ai)
#pragma unroll
            for (int m = 0; m < 4; ++m) {
                const int row = row0 + ai * HALF + m * 16;
                const float mean = stats[2 * row], rstd = stats[2 * row + 1];
                float* rowp = Y + (size_t)row * D + col0;
                const float* xrow = Xin ? (Xin + (size_t)row * D + col0) : rowp;
#pragma unroll
                for (int bj = 0; bj < 2; ++bj)
#pragma unroll
                    for (int n = 0; n < 2; ++n) {
                        f32x4 xv = *(const f32x4*)(xrow + bj * HALF + n * 16);
                        if (!Xin) xv = (xv - mean) * rstd * gv[bj][n] + bv[bj][n];
                        *(f32x4*)(rowp + bj * HALF + n * 16) = xv * ALPHA + acc[ai][bj][m][n] * scale;
                    }
            }
    }
};
struct EpiExp {
    static constexpr bool PERM = true;
    bf16_t* P; float* psum;
    __device__ __forceinline__ void operator()(const f32x4 (&acc)[2][2][4][2], const Unit& u, int wr, int wc, int fr, int fq) const {
        const int row0 = u.pm * BM + wr * 64 + fr, col0 = wc * 32 + 8 * fq;
#pragma unroll
        for (int ai = 0; ai < 2; ++ai)
#pragma unroll
            for (int m = 0; m < 4; ++m) {
                const int row = row0 + ai * HALF + m * 16;
                bf16_t* rowp = P + (size_t)row * 256 + col0;
                float s = 0.f;
#pragma unroll
                for (int bj = 0; bj < 2; ++bj) {
                    unsigned e[8];
#pragma unroll
                    for (int j = 0; j < 4; ++j) { e[j] = f2bf(__expf(fminf(acc[ai][bj][m][0][j], 80.f))); e[4 + j] = f2bf(__expf(fminf(acc[ai][bj][m][1][j], 80.f))); }
#pragma unroll
                    for (int j = 0; j < 8; ++j) s += __uint_as_float(e[j] << 16);
                    u32x4 w; w.x = e[0] | (e[1] << 16); w.y = e[2] | (e[3] << 16); w.z = e[4] | (e[5] << 16); w.w = e[6] | (e[7] << 16);
                    *(u32x4*)(rowp + bj * HALF) = w;
                }
                s += __shfl_xor(s, 16); s += __shfl_xor(s, 32);
                if (fq == 0) psum[(size_t)row * 4 + wc] = s;
            }
    }
};
struct EpiPV {
    static constexpr bool PERM = true;
    bf16_t* O; const float* psum;
    __device__ __forceinline__ void operator()(const f32x4 (&acc)[2][2][4][2], const Unit& u, int wr, int wc, int fr, int fq) const {
        const int b = u.pm >> 5, h = (u.pm >> 3) & 3, mt = u.pm & 7;
        const int rl0 = wr * 64 + fr, col0 = h * 256 + wc * 32 + 8 * fq;
#pragma unroll
        for (int ai = 0; ai < 2; ++ai)
#pragma unroll
            for (int m = 0; m < 4; ++m) {
                const int rl = rl0 + ai * HALF + m * 16;
                const f32x4 ps = *(const f32x4*)(psum + ((size_t)u.pm * 256 + rl) * 4);
                const float inv = 1.0f / ((ps[0] + ps[1]) + (ps[2] + ps[3]));
                bf16_t* rowp = O + (size_t)(b * SEQ + mt * 256 + rl) * D + col0;
#pragma unroll
                for (int bj = 0; bj < 2; ++bj) {
                    const f32x4 v0 = acc[ai][bj][m][0] * inv, v1 = acc[ai][bj][m][1] * inv;
                    u32x4 w; w.x = pk2(v0[0], v0[1]); w.y = pk2(v0[2], v0[3]); w.z = pk2(v1[0], v1[1]); w.w = pk2(v1[2], v1[3]);
                    *(u32x4*)(rowp + bj * HALF) = w;
                }
                __builtin_amdgcn_sched_barrier(0);
            }
    }
};

template <class Prob, class Epi>
__device__ __forceinline__ void gemm_phase(LAS unsigned char* lds, const Prob& S, const Epi& E) {
    const int tid = otid(), wid = __builtin_amdgcn_readfirstlane(tid >> 6), lane = tid & 63, wr = wid >> 2, wc = wid & 3, fr = lane & 15, fq = lane >> 4;
    const int K = S.K, nt = K / BK, lda = S.lda, ldb = S.ldb;
    unsigned voffA[2], voffB[2];
#pragma unroll
    for (int i = 0; i < 2; ++i) { int R, C; stage_rc(tid * 16 + i * 8192, R, C); const int Rb = Epi::PERM ? ((R & ~31) + perm32(R & 31)) : R;
        voffA[i] = (unsigned)(R * lda + C) * 2u; voffB[i] = (unsigned)(Rb * ldb + C) * 2u; }
    const size_t kstep = (size_t)(BK * 2);
    const size_t hA = (size_t)HALF * lda * 2, hB = (size_t)HALF * ldb * 2;
    const unsigned ldsw = (unsigned)wid * 1024u;
    const int aoff = lds_byte(wr * 64 + fr, fq * 8), boff = lds_byte(wc * 32 + fr, fq * 8);
#define PG8_SA(b, h) (((b) * 2 + (h)) * HTB)
#define PG8_SB(b, h) ((4 + (b) * 2 + (h)) * HTB)
#define PG8_STAGE(bufoff, gbase, voff) do { _Pragma("unroll") for (int _i = 0; _i < 2; ++_i) \
        __builtin_amdgcn_global_load_lds((const unsigned*)((const char*)(gbase) + (voff)[_i]), (LAS unsigned*)(lds + (bufoff) + ldsw + _i * 8192), 16, 0, 0); } while (0)
#define PG8_LDA(dst, b, h) do { _Pragma("unroll") for (int m = 0; m < 4; ++m) _Pragma("unroll") for (int k = 0; k < 2; ++k) dst[m][k] = *(const LAS bf16x8*)(lds + PG8_SA(b, h) + aoff + m * 2048 + k * 1024); } while (0)
#define PG8_LDB(dst, b, h) do { _Pragma("unroll") for (int n = 0; n < 2; ++n) _Pragma("unroll") for (int k = 0; k < 2; ++k) dst[n][k] = *(const LAS bf16x8*)(lds + PG8_SB(b, h) + boff + n * 2048 + k * 1024); } while (0)
#define PG8_MMA(ai, bj, At, Bt) do { __builtin_amdgcn_s_setprio(1); _Pragma("unroll") for (int m = 0; m < 4; ++m) _Pragma("unroll") for (int n = 0; n < 2; ++n) _Pragma("unroll") for (int k = 0; k < 2; ++k) \
        acc[ai][bj][m][n] = __builtin_amdgcn_mfma_f32_16x16x32_bf16(Bt[n][k], At[m][k], acc[ai][bj][m][n], 0, 0, 0); __builtin_amdgcn_s_setprio(0); } while (0)
#define PG8_WAIT_V(n) asm volatile("s_waitcnt vmcnt(" #n ")" ::: "memory")
#define PG8_WAIT_L(n) asm volatile("s_waitcnt lgkmcnt(" #n ")" ::: "memory")
#define PG8_BAR __builtin_amdgcn_s_barrier()
#define PG8_SCHED __builtin_amdgcn_sched_barrier(0)
    Unit cur, nxt; int ui = 0;
    if (!S.next(0, cur)) return;
    f32x4 acc[2][2][4][2];
#pragma unroll
    for (int a = 0; a < 2; ++a)
#pragma unroll
        for (int b = 0; b < 2; ++b)
#pragma unroll
            for (int m = 0; m < 4; ++m)
#pragma unroll
                for (int n = 0; n < 2; ++n) acc[a][b][m][n] = (f32x4){0.f, 0.f, 0.f, 0.f};
    bf16x8 At[4][2], B0[2][2], B1[2][2];
    const char* cA = S.aptr(cur); const char* cB = S.bptr(cur);
    PG8_STAGE(PG8_SB(0, 0), cB, voffB); PG8_STAGE(PG8_SA(0, 0), cA, voffA); PG8_STAGE(PG8_SB(0, 1), cB + hB, voffB); PG8_STAGE(PG8_SA(0, 1), cA + hA, voffA);
    if (wr == 1) PG8_BAR;
    PG8_WAIT_V(4); PG8_BAR;
    PG8_STAGE(PG8_SB(1, 0), cB + kstep, voffB); PG8_STAGE(PG8_SA(1, 0), cA + kstep, voffA); PG8_STAGE(PG8_SB(1, 1), cB + hB + kstep, voffB);
    PG8_WAIT_V(6); PG8_BAR;
    for (;;) {
        const bool has_next = S.next(ui + 1, nxt);
        const char* nA = has_next ? S.aptr(nxt) : cA; const char* nB = has_next ? S.bptr(nxt) : cB;
        for (int t = 0; t < nt; t += 2) {
            const bool last = (t == nt - 2);
            const char* a1 = cA + (size_t)(t + 1) * kstep;
            const char* a2 = last ? nA : cA + (size_t)(t + 2) * kstep; const char* b2 = last ? nB : cB + (size_t)(t + 2) * kstep;
            const char* a3 = a2 + kstep; const char* b3 = b2 + kstep;
            PG8_LDB(B0, 0, 0); PG8_SCHED; PG8_LDA(At, 0, 0); PG8_STAGE(PG8_SA(1, 1), a1 + hA, voffA);
            PG8_WAIT_L(8); PG8_BAR; PG8_WAIT_L(0); PG8_MMA(0, 0, At, B0); PG8_BAR; PG8_SCHED;
            PG8_LDB(B1, 0, 1); PG8_STAGE(PG8_SB(0, 0), b2, voffB);
            PG8_BAR; PG8_WAIT_L(0); PG8_MMA(0, 1, At, B1); PG8_BAR;
            PG8_LDA(At, 0, 1); PG8_STAGE(PG8_SA(0, 0), a2, voffA);
            PG8_BAR; PG8_WAIT_L(0); PG8_MMA(1, 0, At, B0); PG8_BAR; PG8_SCHED;
            PG8_STAGE(PG8_SB(0, 1), b2 + hB, voffB);
            PG8_WAIT_V(6); PG8_BAR; PG8_MMA(1, 1, At, B1); PG8_BAR;
            PG8_LDB(B0, 1, 0); PG8_SCHED; PG8_LDA(At, 1, 0); PG8_STAGE(PG8_SA(0, 1), a2 + hA, voffA);
            PG8_WAIT_L(8); PG8_BAR; PG8_WAIT_L(0); PG8_MMA(0, 0, At, B0); PG8_BAR; PG8_SCHED;
            PG8_LDB(B1, 1, 1); PG8_STAGE(PG8_SB(1, 0), b3, voffB);
            PG8_BAR; PG8_WAIT_L(0); PG8_MMA(0, 1, At, B1); PG8_BAR;
            PG8_LDA(At, 1, 1); PG8_STAGE(PG8_SA(1, 0), a3, voffA);
            PG8_BAR; PG8_WAIT_L(0); PG8_MMA(1, 0, At, B0); PG8_BAR; PG8_SCHED;
            PG8_STAGE(PG8_SB(1, 1), b3 + hB, voffB);
            PG8_WAIT_V(6); PG8_BAR; PG8_MMA(1, 1, At, B1); PG8_BAR;
        }
        E(acc, cur, wr, wc, fr, fq);
        if (!has_next) break;
#pragma unroll
        for (int a = 0; a < 2; ++a)
#pragma unroll
            for (int b = 0; b < 2; ++b)
#pragma unroll
                for (int m = 0; m < 4; ++m)
#pragma unroll
                    for (int n = 0; n < 2; ++n) acc[a][b][m][n] = (f32x4){0.f, 0.f, 0.f, 0.f};
        cur = nxt; cA = nA; cB = nB; ++ui;
    }
    PG8_WAIT_V(0);
    if (wr == 0) PG8_BAR;
    PG8_BAR;
#undef PG8_SA
#undef PG8_SB
#undef PG8_STAGE
#undef PG8_LDA
#undef PG8_LDB
#undef PG8_MMA
#undef PG8_WAIT_V
#undef PG8_WAIT_L
#undef PG8_BAR
#undef PG8_SCHED
}

struct Args { const float* in[33]; float* out; unsigned char* ws; int ph_lo, ph_hi; };
enum { I_X = 0, I_MEM, I_F1IN, I_F1OUT, I_LN1G, I_LN1B, I_MIXIN, I_RGCW, I_RGCB, I_RGWR, I_RGBR, I_RGWI, I_RGBI, I_RGLAM, I_GLAWG, I_GLABG, I_GLANG,
       I_CVW, I_CVB, I_CVGG, I_CVGB, I_MIXOUT, I_LN2G, I_LN2B, I_XAQ, I_XAKV, I_XAO, I_LN3G, I_LN3B, I_F2IN, I_F2OUT, I_LN4G, I_LN4B };

__device__ __forceinline__ void transpose_item(const float* W, int K, int Nsrc, int k0, int n0, bf16_t* WT, int drow0, LAS float* scr, int lane) {
    const int col = n0 + (lane & 31); const bool ok = col < Nsrc;
#pragma unroll 8
    for (int i = 0; i < 32; ++i) { const int kk = 2 * i + (lane >> 5); scr[kk * 33 + (lane & 31)] = ok ? W[(size_t)(k0 + kk) * Nsrc + col] : 0.f; }
    LDS_WAIT();
    const int c = lane & 7;
#pragma unroll
    for (int j = 0; j < 4; ++j) { const int n = (lane >> 3) + 8 * j; const LAS float* s = scr + (8 * c) * 33 + n;
        u32x4 o; o.x = pk2(s[0 * 33], s[1 * 33]); o.y = pk2(s[2 * 33], s[3 * 33]); o.z = pk2(s[4 * 33], s[5 * 33]); o.w = pk2(s[6 * 33], s[7 * 33]);
        *(u32x4*)(WT + (size_t)(drow0 + n) * K + k0 + 8 * c) = o; }
    LDS_WAIT();
}
__device__ __forceinline__ int w1_row(int n0) { const int up = n0 >= FF ? 1 : 0, j = n0 - up * FF; return 256 * (j >> 7) + 128 * up + (j & 127); }

__device__ __forceinline__ void convert_weights(const Args& a, int l, LAS unsigned char* lds) {
    const int tid_ = otid(); const int lane = tid_ & 63, wave = tid_ >> 6;
    LAS float* scr = (LAS float*)(lds + wave * 16384);
    const int gw = blockIdx.x * 8 + wave, NGW = gridDim.x * 8;
    unsigned char* ws = a.ws;
    constexpr int I_1 = (D / 64) * (2 * FF / 32), I_2 = (FF / 64) * (D / 32), I_IN = (D / 64) * (NINP / 32), I_SQ = (D / 64) * (D / 32), I_KV = (D / 64) * (2 * D / 32);
    constexpr int NITEMS = 2 * I_1 + 2 * I_2 + I_IN + 3 * I_SQ + I_KV;
    for (int it = gw; it < NITEMS; it += NGW) {
        int r = it;
        if (r < I_1) { const int nb = 2 * FF / 32, kb = r / nb, n0 = (r % nb) * 32; transpose_item(a.in[I_F1IN] + (size_t)l * D * 2 * FF, D, 2 * FF, kb * 64, n0, (bf16_t*)(ws + WS_W1T_A), w1_row(n0), scr, lane); continue; } r -= I_1;
        if (r < I_1) { const int nb = 2 * FF / 32, kb = r / nb, n0 = (r % nb) * 32; transpose_item(a.in[I_F2IN] + (size_t)l * D * 2 * FF, D, 2 * FF, kb * 64, n0, (bf16_t*)(ws + WS_W1T_B), w1_row(n0), scr, lane); continue; } r -= I_1;
        if (r < I_2) { const int nb = D / 32, kb = r / nb, n0 = (r % nb) * 32; transpose_item(a.in[I_F1OUT] + (size_t)l * FF * D, FF, D, kb * 64, n0, (bf16_t*)(ws + WS_W2T_A), n0, scr, lane); continue; } r -= I_2;
        if (r < I_2) { const int nb = D / 32, kb = r / nb, n0 = (r % nb) * 32; transpose_item(a.in[I_F2OUT] + (size_t)l * FF * D, FF, D, kb * 64, n0, (bf16_t*)(ws + WS_W2T_B), n0, scr, lane); continue; } r -= I_2;
        if (r < I_IN) { const int nb = NINP / 32, kb = r / nb, n0 = (r % nb) * 32; transpose_item(a.in[I_MIXIN] + (size_t)l * D * NIN, D, NIN, kb * 64, n0, (bf16_t*)(ws + WS_WINT), n0, scr, lane); continue; } r -= I_IN;
        if (r < I_SQ) { const int nb = D / 32, kb = r / nb, n0 = (r % nb) * 32; transpose_item(a.in[I_MIXOUT] + (size_t)l * D * D, D, D, kb * 64, n0, (bf16_t*)(ws + WS_WOUTT), n0, scr, lane); continue; } r -= I_SQ;
        if (r < I_SQ) { const int nb = D / 32, kb = r / nb, n0 = (r % nb) * 32; transpose_item(a.in[I_XAQ] + (size_t)l * D * D, D, D, kb * 64, n0, (bf16_t*)(ws + WS_WQT), n0, scr, lane); continue; } r -= I_SQ;
        if (r < I_SQ) { const int nb = D / 32, kb = r / nb, n0 = (r % nb) * 32; transpose_item(a.in[I_XAO] + (size_t)l * D * D, D, D, kb * 64, n0, (bf16_t*)(ws + WS_WOT), n0, scr, lane); continue; } r -= I_SQ;
        { const int nb = 2 * D / 32, kb = r / nb, n0 = (r % nb) * 32; transpose_item(a.in[I_XAKV] + (size_t)l * D * 2 * D, D, 2 * D, kb * 64, n0, (bf16_t*)(ws + WS_WKVT), n0, scr, lane); }
    }
}
__device__ __forceinline__ void cvt_rows(const float* src, bf16_t* dst, size_t n) {
    const size_t g = (size_t)blockIdx.x * NTHREADS + otid(), NT = (size_t)gridDim.x * NTHREADS;
    for (size_t i = g; i < n / 4; i += NT) { const f32x4 v = ((const f32x4*)src)[i]; u32x2 o; o.x = pk2(v[0], v[1]); o.y = pk2(v[2], v[3]); ((u32x2*)dst)[i] = o; }
}
__device__ __forceinline__ void ln_phase(const float* Y, const float* g, const float* b, bf16_t* XN, float* stats, float* out) {
    const int tid_ = otid(); const int lane = tid_ & 63, wave = tid_ >> 6;
    const int gw = blockIdx.x * 8 + wave, NGW = gridDim.x * 8;
    f32x4 gv[4], bv[4];
#pragma unroll
    for (int j = 0; j < 4; ++j) { gv[j] = ((const f32x4*)g)[64 * j + lane]; bv[j] = ((const f32x4*)b)[64 * j + lane]; }
    for (int row = gw; row < MTOK; row += NGW) {
        const f32x4* xr = (const f32x4*)(Y + (size_t)row * D) + lane;
        f32x4 v[4]; float s = 0.f;
#pragma unroll
        for (int j = 0; j < 4; ++j) { v[j] = xr[64 * j]; s += (v[j][0] + v[j][1]) + (v[j][2] + v[j][3]); }
        const float mean = wave_sum(s) * (1.f / D); float s2 = 0.f;
#pragma unroll
        for (int j = 0; j < 4; ++j) { const f32x4 d = v[j] - mean; s2 += (d[0] * d[0] + d[1] * d[1]) + (d[2] * d[2] + d[3] * d[3]); }
        const float rstd = 1.0f / sqrtf(wave_sum(s2) * (1.f / D) + EPS);
        if (lane == 0) { stats[2 * row] = mean; stats[2 * row + 1] = rstd; }
        u32x2* o8 = (u32x2*)(XN + (size_t)row * D) + lane;
#pragma unroll
        for (int j = 0; j < 4; ++j) {
            const f32x4 o = (v[j] - mean) * rstd * gv[j] + bv[j];
            u32x2 w; w.x = pk2(o[0], o[1]); w.y = pk2(o[2], o[3]); o8[64 * j] = w;
            if (out) ((f32x4*)(out + (size_t)row * D))[64 * j + lane] = o;
        }
    }
}

__device__ __forceinline__ void rg_local(const Args& a, int l, int item, LAS float* L) {
    const int tid = otid();
    const int hd = item % 6, bn = item / 6, b = bn >> 5, n = bn & 31, t0 = n * 64, tokbase = b * SEQ;
    const bf16_t* PROJ = (const bf16_t*)(a.ws + WS_R1);
    LAS float* xa_s = L; LAS float* xc_s = L + 4288; LAS float* wr_s = L + 8448; LAS float* wi_s = L + 12544; LAS float* a_s = L + 16640; LAS float* u_s = L + 20736;
    for (int e = tid; e < 67 * 64; e += NTHREADS) { const int r = e >> 6, c = e & 63, s = t0 - 3 + r;
        xa_s[e] = s >= 0 ? bf2f(PROJ[(size_t)(tokbase + s) * NINP + C_XA + hd * 64 + c]) : 0.f; }
    { const float* wr = a.in[I_RGWR] + (size_t)(l * 6 + hd) * 4096; const float* wi = a.in[I_RGWI] + (size_t)(l * 6 + hd) * 4096;
      for (int e = tid; e < 4096; e += NTHREADS) { wr_s[e] = wr[e]; wi_s[e] = wi[e]; } }
    __syncthreads();
    { const float* cw = a.in[I_RGCW] + (size_t)l * 4 * WA; const float* cb = a.in[I_RGCB] + (size_t)l * WA;
      for (int e = tid; e < 4096; e += NTHREADS) { const int t = e >> 6, c = e & 63, ch = hd * 64 + c; float acc = cb[ch];
#pragma unroll
          for (int k = 0; k < 4; ++k) acc += cw[k * WA + ch] * xa_s[(t + k) * 64 + c];
          xc_s[t * 65 + c] = acc; } }
    __syncthreads();
    { const int t = tid >> 3, jg = tid & 7;
      float racc[8], iacc[8];
#pragma unroll
      for (int j = 0; j < 8; ++j) { racc[j] = 0.f; iacc[j] = 0.f; }
      for (int i = 0; i < 64; ++i) {
          const float x = xc_s[t * 65 + i];
          const f32x4 r0 = *(const LAS f32x4*)(wr_s + i * 64 + jg * 8), r1 = *(const LAS f32x4*)(wr_s + i * 64 + jg * 8 + 4);
          const f32x4 i0 = *(const LAS f32x4*)(wi_s + i * 64 + jg * 8), i1 = *(const LAS f32x4*)(wi_s + i * 64 + jg * 8 + 4);
#pragma unroll
          for (int j = 0; j < 4; ++j) { racc[j] += x * r0[j]; racc[4 + j] += x * r1[j]; iacc[j] += x * i0[j]; iacc[4 + j] += x * i1[j]; }
      }
      const float* br = a.in[I_RGBR] + (size_t)l * WA + hd * 64; const float* bi = a.in[I_RGBI] + (size_t)l * WA + hd * 64; const float* lam = a.in[I_RGLAM] + (size_t)l * WA + hd * 64;
#pragma unroll
      for (int jj = 0; jj < 8; ++jj) { const int j = jg * 8 + jj;
          const float r = sigmoidf_(racc[jj] + br[j]), ig = sigmoidf_(iacc[jj] + bi[j]);
          const float z = -lam[j]; const float sp = fmaxf(z, 0.f) + log1pf(__expf(-fabsf(z)));
          const float log_a = -8.0f * r * sp; const float av = __expf(log_a);
          const float uv = sqrtf(-expm1f(2.0f * log_a)) * (ig * xc_s[t * 65 + j]);
          a_s[t * 64 + j] = av; u_s[t * 64 + j] = uv; }
    }
    __syncthreads();
    if (tid < 64) { const int c = tid; float H = 0.f, P = 1.f;
        float* HLOC = (float*)(a.ws + WS_HLOC); float* ACUM = (float*)(a.ws + WS_ACUM);
        for (int t = 0; t < 64; ++t) { const float av = a_s[t * 64 + c]; H = av * H + u_s[t * 64 + c]; P *= av;
            const size_t idx = (size_t)(tokbase + t0 + t) * WA + hd * 64 + c; HLOC[idx] = H; ACUM[idx] = P; }
        ((float*)(a.ws + WS_AEND))[(size_t)bn * WA + hd * 64 + c] = P; ((float*)(a.ws + WS_HEND))[(size_t)bn * WA + hd * 64 + c] = H; }
    __syncthreads();
}
__device__ __forceinline__ void gla_bcum(const Args& a, int l, int tok0, int h, LAS float* lr_s, LAS float* wg_s, LAS float* bg_s, LAS float* bc_s) {
    const int tid = otid();
    const bf16_t* PROJ = (const bf16_t*)(a.ws + WS_R1);
    for (int e = tid; e < 1024; e += NTHREADS) { const int t = e >> 4, r = e & 15; lr_s[e] = bf2f(PROJ[(size_t)(tok0 + t) * NINP + C_LR + r]); }
    for (int e = tid; e < 768; e += NTHREADS) { const int r = e / 48, d = e % 48; wg_s[e] = a.in[I_GLAWG][(size_t)(l * 16 + r) * 192 + h * 48 + d]; }
    if (tid < 48) bg_s[tid] = a.in[I_GLABG][(size_t)l * 192 + h * 48 + tid];
    __syncthreads();
    for (int e = tid; e < 3072; e += NTHREADS) { const int t = e / 48, d = e % 48; float acc = bg_s[d];
#pragma unroll
        for (int r = 0; r < 16; ++r) acc += lr_s[t * 16 + r] * wg_s[r * 48 + d];
        const float ls = fminf(acc, 0.f) - log1pf(__expf(-fabsf(acc)));
        bc_s[e] = ls * (1.0f / 16.0f); }
    __syncthreads();
    if (tid < 48) { float s = 0.f; for (int t = 0; t < 64; ++t) { s += bc_s[t * 48 + tid]; bc_s[t * 48 + tid] = s; } }
    __syncthreads();
}
__device__ __forceinline__ void gla1(const Args& a, int l, int item, LAS float* L) {
    const int tid = otid();
    const int h = item & 3, bn = item >> 2, b = bn >> 5, n = bn & 31, tok0 = b * SEQ + n * 64;
    const bf16_t* PROJ = (const bf16_t*)(a.ws + WS_R1);
    LAS float* lr_s = L; LAS float* wg_s = L + 1024; LAS float* bg_s = L + 1792; LAS float* bc_s = L + 1856; LAS float* k_s = L + 4928; LAS float* v_s = L + 8000;
    for (int e = tid; e < 3072; e += NTHREADS) { const int t = e / 48, d = e % 48; k_s[e] = bf2f(PROJ[(size_t)(tok0 + t) * NINP + C_K + h * 48 + d]); }
    for (int e = tid; e < 6144; e += NTHREADS) { const int t = e / 96, c = e % 96; v_s[e] = bf2f(PROJ[(size_t)(tok0 + t) * NINP + C_V + h * 96 + c]); }
    gla_bcum(a, l, tok0, h, lr_s, wg_s, bg_s, bc_s);
    for (int e = tid; e < 3072; e += NTHREADS) { const int d = e % 48; k_s[e] *= __expf(bc_s[63 * 48 + d] - bc_s[e]); }
    __syncthreads();
    { const int dg = tid >> 5, eg = tid & 31; float acc[3][3];
#pragma unroll
      for (int x = 0; x < 3; ++x)
#pragma unroll
          for (int y = 0; y < 3; ++y) acc[x][y] = 0.f;
      for (int t = 0; t < 64; ++t) { float kv[3], vv[3];
#pragma unroll
          for (int x = 0; x < 3; ++x) { kv[x] = k_s[t * 48 + dg + 16 * x]; vv[x] = v_s[t * 96 + eg + 32 * x]; }
#pragma unroll
          for (int x = 0; x < 3; ++x)
#pragma unroll
              for (int y = 0; y < 3; ++y) acc[x][y] += kv[x] * vv[y]; }
      float* U = (float*)(a.ws + WS_U) + (size_t)(bn * 4 + h) * 4608;
#pragma unroll
      for (int x = 0; x < 3; ++x)
#pragma unroll
          for (int y = 0; y < 3; ++y) U[(dg + 16 * x) * 96 + eg + 32 * y] = acc[x][y];
      if (tid < 48) ((float*)(a.ws + WS_DEC))[(size_t)(bn * 4 + h) * 48 + tid] = __expf(bc_s[63 * 48 + tid]);
    }
    __syncthreads();
}
__device__ __forceinline__ void conv_item(const Args& a, int l, int item, LAS float* L) {
    const int tid = otid();
    const int b = item >> 6, ck = item & 63, t0 = ck * 32, tokbase = b * SEQ;
    const bf16_t* PROJ = (const bf16_t*)(a.ws + WS_R1);
    bf16_t* CAT = (bf16_t*)(a.ws + WS_CAT);
    for (int e = tid; e < 62 * 256; e += NTHREADS) { const int r = e >> 8, c = e & 255, s = t0 - 30 + r; float v = 0.f;
        if (s >= 0) { const bf16_t* p = PROJ + (size_t)(tokbase + s) * NINP; v = bf2f(p[C_CA + c]) * sigmoidf_(bf2f(p[C_CG + c])); }
        L[e] = v; }
    __syncthreads();
    { const int c = tid & 255, half = tid >> 8;
      float w[31];
#pragma unroll
      for (int k = 0; k < 31; ++k) w[k] = a.in[I_CVW][(size_t)(l * 31 + k) * WCV + c];
      const float bias = a.in[I_CVB][(size_t)l * WCV + c], gg = a.in[I_CVGG][(size_t)l * WCV + c], gb = a.in[I_CVGB][(size_t)l * WCV + c];
      for (int tt = 0; tt < 16; ++tt) { const int t = half * 16 + tt; float u = bias;
#pragma unroll
          for (int k = 0; k < 31; ++k) u += w[k] * L[(t + k) * 256 + c];
          const float mean = wave_sum(u) * (1.f / 64.f); const float dv = u - mean; const float var = wave_sum(dv * dv) * (1.f / 64.f);
          const float un = dv * (1.0f / sqrtf(var + EPS)) * gg + gb;
          CAT[(size_t)(tokbase + t0 + t) * D + 768 + c] = (bf16_t)f2bf(siluf_(un)); }
    }
    __syncthreads();
}
__device__ __forceinline__ void mixer2(const Args& a) {
    const int g = blockIdx.x * NTHREADS + otid(), NT = gridDim.x * NTHREADS;
    { const float* AEND = (const float*)(a.ws + WS_AEND); const float* HEND = (const float*)(a.ws + WS_HEND); float* CIN = (float*)(a.ws + WS_CIN);
      for (int idx = g; idx < NB * WA; idx += NT) { const int b = idx / WA, c = idx % WA; float ae[32], he[32];
#pragma unroll
          for (int n = 0; n < 32; ++n) { ae[n] = AEND[(size_t)(b * 32 + n) * WA + c]; he[n] = HEND[(size_t)(b * 32 + n) * WA + c]; }
          float H = 0.f;
#pragma unroll
          for (int n = 0; n < 32; ++n) { CIN[(size_t)(b * 32 + n) * WA + c] = H; H = ae[n] * H + he[n]; } } }
    { float* U = (float*)(a.ws + WS_U); const float* DEC = (const float*)(a.ws + WS_DEC);
      for (int idx = g; idx < 32 * 4608; idx += NT) { const int bh = idx / 4608, de = idx % 4608, d = de / 96, b = bh >> 2, h = bh & 3; float uv[32], dc[32];
#pragma unroll
          for (int n = 0; n < 32; ++n) { uv[n] = U[(size_t)((b * 32 + n) * 4 + h) * 4608 + de]; dc[n] = DEC[(size_t)((b * 32 + n) * 4 + h) * 48 + d]; }
          float S = 0.f;
#pragma unroll
          for (int n = 0; n < 32; ++n) { U[(size_t)((b * 32 + n) * 4 + h) * 4608 + de] = S; S = dc[n] * S + uv[n]; } } }
}
__device__ __forceinline__ void rg_final(const Args& a) {
    const int g = blockIdx.x * NTHREADS + otid(), NT = gridDim.x * NTHREADS;
    const float* HLOC = (const float*)(a.ws + WS_HLOC); const float* ACUM = (const float*)(a.ws + WS_ACUM); const float* CIN = (const float*)(a.ws + WS_CIN);
    const bf16_t* PROJ = (const bf16_t*)(a.ws + WS_R1); bf16_t* CAT = (bf16_t*)(a.ws + WS_CAT);
    for (int e = g; e < MTOK * WA; e += NT) { const int t = e / WA, c = e % WA;
        const float h = HLOC[e] + ACUM[e] * CIN[(size_t)(t >> 6) * WA + c];
        const float ya = bf2f(PROJ[(size_t)t * NINP + C_YA + c]);
        CAT[(size_t)t * D + c] = (bf16_t)f2bf(h * gelu_tanh(ya)); }
}
__device__ __forceinline__ void gla3(const Args& a, int l, int item, LAS float* L) {
    const int tid = otid();
    const int h = item & 3, bn = item >> 2, b = bn >> 5, n = bn & 31, tok0 = b * SEQ + n * 64;
    const bf16_t* PROJ = (const bf16_t*)(a.ws + WS_R1); bf16_t* CAT = (bf16_t*)(a.ws + WS_CAT);
    LAS float* lr_s = L; LAS float* wg_s = L + 1024; LAS float* bg_s = L + 1792; LAS float* bc_s = L + 1856; LAS float* q_s = L + 4928; LAS float* k_s = L + 8256;
    LAS float* v_s = L + 11584; LAS float* sp_s = L + 17728; LAS float* sc_s = L + 22336;
    for (int e = tid; e < 3072; e += NTHREADS) { const int t = e / 48, d = e % 48; const bf16_t* p = PROJ + (size_t)(tok0 + t) * NINP + h * 48 + d;
        q_s[t * 52 + d] = bf2f(p[C_Q]); k_s[t * 52 + d] = bf2f(p[C_K]); }
    for (int e = tid; e < 6144; e += NTHREADS) { const int t = e / 96, c = e % 96; v_s[e] = bf2f(PROJ[(size_t)(tok0 + t) * NINP + C_V + h * 96 + c]); }
    { const float* U = (const float*)(a.ws + WS_U) + (size_t)(bn * 4 + h) * 4608; for (int e = tid; e < 4608; e += NTHREADS) sp_s[e] = U[e]; }
    gla_bcum(a, l, tok0, h, lr_s, wg_s, bg_s, bc_s);
    for (int e = tid; e < 3072; e += NTHREADS) { const int t = e / 48, d = e % 48; const float bc = bc_s[e];
        q_s[t * 52 + d] *= 0.14433756729740643f * __expf(bc); k_s[t * 52 + d] *= __expf(-bc); }
    __syncthreads();
    { const int ig = tid >> 4, jg = tid & 15; float acc[2][4];
#pragma unroll
      for (int x = 0; x < 2; ++x)
#pragma unroll
          for (int y = 0; y < 4; ++y) acc[x][y] = 0.f;
#pragma unroll 4
      for (int d4 = 0; d4 < 12; ++d4) {
          f32x4 qv[2], kv[4];
#pragma unroll
          for (int x = 0; x < 2; ++x) qv[x] = *(const LAS f32x4*)(q_s + (ig + 32 * x) * 52 + 4 * d4);
#pragma unroll
          for (int y = 0; y < 4; ++y) kv[y] = *(const LAS f32x4*)(k_s + (jg + 16 * y) * 52 + 4 * d4);
#pragma unroll
          for (int x = 0; x < 2; ++x)
#pragma unroll
              for (int y = 0; y < 4; ++y) acc[x][y] += (qv[x][0] * kv[y][0] + qv[x][1] * kv[y][1]) + (qv[x][2] * kv[y][2] + qv[x][3] * kv[y][3]);
      }
#pragma unroll
      for (int x = 0; x < 2; ++x)
#pragma unroll
          for (int y = 0; y < 4; ++y) { const int i = ig + 32 * x, j = jg + 16 * y; sc_s[i * 68 + j] = (j <= i) ? acc[x][y] : 0.f; }
    }
    __syncthreads();
    { const int ig = tid >> 5, eg = tid & 31; float acc[4][3];
#pragma unroll
      for (int x = 0; x < 4; ++x)
#pragma unroll
          for (int y = 0; y < 3; ++y) acc[x][y] = 0.f;
      for (int j4 = 0; j4 < 16; ++j4) {
          f32x4 s4[4];
#pragma unroll
          for (int x = 0; x < 4; ++x) s4[x] = *(const LAS f32x4*)(sc_s + (ig + 16 * x) * 68 + 4 * j4);
#pragma unroll
          for (int jj = 0; jj < 4; ++jj) { float vv[3];
#pragma unroll
              for (int y = 0; y < 3; ++y) vv[y] = v_s[(4 * j4 + jj) * 96 + eg + 32 * y];
#pragma unroll
              for (int x = 0; x < 4; ++x)
#pragma unroll
                  for (int y = 0; y < 3; ++y) acc[x][y] += s4[x][jj] * vv[y]; }
      }
      for (int d4 = 0; d4 < 12; ++d4) {
          f32x4 q4[4];
#pragma unroll
          for (int x = 0; x < 4; ++x) q4[x] = *(const LAS f32x4*)(q_s + (ig + 16 * x) * 52 + 4 * d4);
#pragma unroll
          for (int dd = 0; dd < 4; ++dd) { float sv[3];
#pragma unroll
              for (int y = 0; y < 3; ++y) sv[y] = sp_s[(4 * d4 + dd) * 96 + eg + 32 * y];
#pragma unroll
              for (int x = 0; x < 4; ++x)
#pragma unroll
                  for (int y = 0; y < 3; ++y) acc[x][y] += q4[x][dd] * sv[y]; }
      }
      const float* ng = a.in[I_GLANG] + (size_t)l * 96;
#pragma unroll
      for (int x = 0; x < 4; ++x) { const int i = ig + 16 * x;
          float ss = acc[x][0] * acc[x][0] + acc[x][1] * acc[x][1] + acc[x][2] * acc[x][2];
#pragma unroll
          for (int o = 1; o < 32; o <<= 1) ss += __shfl_xor(ss, o);
          const float r = 1.0f / sqrtf(ss * (1.f / 96.f) + EPS);
#pragma unroll
          for (int y = 0; y < 3; ++y) { const int e = eg + 32 * y;
              const float gate = bf2f(PROJ[(size_t)(tok0 + i) * NINP + C_G + h * 96 + e]);
              CAT[(size_t)(tok0 + i) * D + WA + h * 96 + e] = (bf16_t)f2bf(acc[x][y] * r * ng[e] * siluf_(gate)); } }
    }
    __syncthreads();
}

constexpr int PH_PER_LAYER = 17, N_PHASES = 1 + DEPTH * PH_PER_LAYER;

__device__ __forceinline__ void run_phase(const Args& a, int p, LAS unsigned char* lds) {
    unsigned char* ws = a.ws;
    const int G = gridDim.x, bx = blockIdx.x;
    bf16_t* XN = (bf16_t*)(ws + WS_XN); float* Y = (float*)(ws + WS_Y); float* STATS = (float*)(ws + WS_STATS);
    if (p == 0) {
        convert_weights(a, 0, lds);
        cvt_rows(a.in[I_X], XN, (size_t)MTOK * D);
        cvt_rows(a.in[I_MEM], (bf16_t*)(ws + WS_MEMB), (size_t)MMEM * D);
        return;
    }
    const int l = (p - 1) / PH_PER_LAYER, s = (p - 1) % PH_PER_LAYER;
#ifdef TEST_ONLY
    if (s != TEST_ONLY) return;
#endif
    switch (s) {
    case 0: case 14: {
        StdProb S; S.init(XN, (const bf16_t*)(ws + (s == 0 ? WS_W1T_A : WS_W1T_B)), D, D, D, MTOK, 2 * FF, G, bx);
        EpiSwiGLU E{(bf16_t*)(ws + WS_R1)};
        gemm_phase(lds, S, E);
    } break;
    case 1: case 7: case 12: case 15: {
        const bf16_t* A; const bf16_t* Bt; int K; const float* g; const float* b; float scale; const float* Xin = nullptr;
        if (s == 1) { A = (const bf16_t*)(ws + WS_R1); Bt = (const bf16_t*)(ws + WS_W2T_A); K = FF; scale = 0.5f;
            if (l == 0) { Xin = a.in[I_X]; g = a.in[I_LN4G]; b = a.in[I_LN4B]; } else { g = a.in[I_LN4G] + (size_t)(l - 1) * D; b = a.in[I_LN4B] + (size_t)(l - 1) * D; } }
        else if (s == 7) { A = (const bf16_t*)(ws + WS_CAT); Bt = (const bf16_t*)(ws + WS_WOUTT); K = D; scale = 1.0f; g = a.in[I_LN1G] + (size_t)l * D; b = a.in[I_LN1B] + (size_t)l * D; }
        else if (s == 12) { A = (const bf16_t*)(ws + WS_CAT); Bt = (const bf16_t*)(ws + WS_WOT); K = D; scale = 1.0f; g = a.in[I_LN2G] + (size_t)l * D; b = a.in[I_LN2B] + (size_t)l * D; }
        else { A = (const bf16_t*)(ws + WS_R1); Bt = (const bf16_t*)(ws + WS_W2T_B); K = FF; scale = 0.5f; g = a.in[I_LN3G] + (size_t)l * D; b = a.in[I_LN3B] + (size_t)l * D; }
        StdProb S; S.init(A, Bt, K, K, K, MTOK, D, G, bx);
        EpiRes E{Y, Xin, STATS, g, b, scale};
        gemm_phase(lds, S, E);
    } break;
    case 2: case 8: case 13: case 16: {
        const float* gp = s == 2 ? a.in[I_LN1G] : s == 8 ? a.in[I_LN2G] : s == 13 ? a.in[I_LN3G] : a.in[I_LN4G];
        const float* bp = s == 2 ? a.in[I_LN1B] : s == 8 ? a.in[I_LN2B] : s == 13 ? a.in[I_LN3B] : a.in[I_LN4B];
        const bool fin = (s == 16 && l == DEPTH - 1);
        ln_phase(Y, gp + (size_t)l * D, bp + (size_t)l * D, XN, STATS, fin ? a.out : nullptr);
        if (s == 16 && l + 1 < DEPTH) convert_weights(a, l + 1, lds);
    } break;
    case 3: {
        { StdProb S; S.init(XN, (const bf16_t*)(ws + WS_WINT), D, D, D, MTOK, NINP, G, bx);
          EpiBf16 E{(bf16_t*)(ws + WS_R1), NINP, 1.0f}; gemm_phase(lds, S, E); }
        { StdProb S; S.init((const bf16_t*)(ws + WS_MEMB), (const bf16_t*)(ws + WS_WKVT), D, D, D, MMEM, D, G, (bx + G - (G / 2)) % G);
          EpiBf16 E{(bf16_t*)(ws + WS_KM), D, 1.0f}; gemm_phase(lds, S, E); }
        { StdProb S; S.init((const bf16_t*)(ws + WS_WKVT) + (size_t)D * D, (const bf16_t*)(ws + WS_MEMB), D, D, D, D, MMEM, G, (bx + G - (G / 2 + 32)) % G);
          EpiBf16 E{(bf16_t*)(ws + WS_VT), MMEM, 1.0f}; gemm_phase(lds, S, E); }
    } break;
    case 4: {
        LAS float* L = (LAS float*)lds;
        for (int it = bx; it < 3072; it += G) { if (it < 1536) rg_local(a, l, it, L); else if (it < 2560) gla1(a, l, it - 1536, L); else conv_item(a, l, it - 2560, L); }
    } break;
    case 5: mixer2(a); break;
    case 6: {
        LAS float* L = (LAS float*)lds;
        rg_final(a);
        for (int it = bx; it < 1024; it += G) gla3(a, l, it, L);
    } break;
    case 9: {
        StdProb S; S.init(XN, (const bf16_t*)(ws + WS_WQT), D, D, D, MTOK, D, G, bx);
        EpiBf16 E{(bf16_t*)(ws + WS_R1), D, 0.0625f}; gemm_phase(lds, S, E);
    } break;
    case 10: {
        ScoreProb S{(const bf16_t*)(ws + WS_R1), (const bf16_t*)(ws + WS_KM), D, D, 256, G, bx};
        EpiExp E{(bf16_t*)(ws + WS_R1 + R1_P_OFF), (float*)(ws + WS_PSUM)}; gemm_phase(lds, S, E);
    } break;
    case 11: {
        PVProb S{(const bf16_t*)(ws + WS_R1 + R1_P_OFF), (const bf16_t*)(ws + WS_VT), 256, MMEM, 256, G, bx};
        EpiPV E{(bf16_t*)(ws + WS_CAT), (const float*)(ws + WS_PSUM)}; gemm_phase(lds, S, E);
    } break;
    default: break;
    }
}

__global__ void __launch_bounds__(NTHREADS, 2) fwd_megakernel(Args args) {
    extern __shared__ __attribute__((aligned(16))) unsigned char lds_raw[];
    LAS unsigned char* lds = (LAS unsigned char*)lds_raw;
    cg::grid_group grid = cg::this_grid();
    for (int p = args.ph_lo; p < args.ph_hi; ++p) {
        run_phase(args, p, lds);
        if (p + 1 < args.ph_hi) grid.sync();
    }
}

extern "C" void kernel_launch(void* const* d_in, const int* in_sizes, int n_in, void* d_out, int out_size, void* d_ws, size_t ws_size, hipStream_t stream) {
    static int grid = 0;
    if (grid == 0) {
        if (n_in != 33 || ws_size < WS_END) { fprintf(stderr, "kernel_launch: unexpected n_in %d or ws_size %zu (need %zu)\n", n_in, ws_size, (size_t)WS_END); grid = -1; return; }
        int dev = 0, cus = 0, per_cu = 0;
        (void)hipGetDevice(&dev);
        (void)hipDeviceGetAttribute(&cus, hipDeviceAttributeMultiprocessorCount, dev);
        if (hipFuncSetAttribute((const void*)fwd_megakernel, hipFuncAttributeMaxDynamicSharedMemorySize, LDS_BYTES) != hipSuccess) { fprintf(stderr, "kernel_launch: hipFuncSetAttribute failed\n"); grid = -1; return; }
        if (hipOccupancyMaxActiveBlocksPerMultiprocessor(&per_cu, (const void*)fwd_megakernel, NTHREADS, LDS_BYTES) != hipSuccess || per_cu < 1) { fprintf(stderr, "kernel_launch: occupancy query says %d\n", per_cu); per_cu = 1; }
        (void)hipGetLastError();
        grid = cus > 0 ? cus : 256;
    }
    if (grid < 0) return;
    Args a{};
    for (int i = 0; i < 33; ++i) a.in[i] = (const float*)d_in[i];
    a.out = (float*)d_out; a.ws = (unsigned char*)d_ws; a.ph_lo = 0; a.ph_hi = N_PHASES;
    void* kargs[] = {&a};
    hipError_t e = hipLaunchCooperativeKernel((const void*)fwd_megakernel, dim3(grid), dim3(NTHREADS), kargs, LDS_BYTES, stream);
    if (e != hipSuccess) fprintf(stderr, "cooperative launch failed: %s (grid %d)\n", hipGetErrorString(e), grid);
}
```

```cpp
#include <hip/hip_runtime.h>
#include <hip/hip_cooperative_groups.h>
#include <cstdio>
#include <cstdint>
namespace cg = cooperative_groups;

#define LAS __attribute__((address_space(3)))
typedef unsigned short bf16_t;
typedef short bf16x8 __attribute__((ext_vector_type(8)));
typedef float f32x4 __attribute__((ext_vector_type(4)));
typedef unsigned u32x4 __attribute__((ext_vector_type(4)));
typedef unsigned u32x2 __attribute__((ext_vector_type(2)));

constexpr int NB = 8, SEQ = 2048, MTOK = NB * SEQ, D = 1024, FF = 2816, NIN = 2448, NINP = 2560, DEPTH = 4, MEML = 256, MMEM = NB * MEML;
constexpr int WA = 384, WCV = 256;
constexpr float ALPHA = 1.6817928305074290f;
constexpr float EPS = 1e-5f;
constexpr int C_XA = 0, C_YA = 384, C_Q = 768, C_K = 960, C_V = 1152, C_G = 1536, C_LR = 1920, C_CA = 1936, C_CG = 2192;
constexpr int NTHREADS = 512;
constexpr int LDS_BYTES = 144 * 1024;

constexpr size_t al256(size_t x) { return (x + 255) & ~(size_t)255; }
constexpr size_t WS_W1T_A = 0;
constexpr size_t WS_W2T_A = WS_W1T_A + al256((size_t)2 * FF * D * 2);
constexpr size_t WS_W1T_B = WS_W2T_A + al256((size_t)D * FF * 2);
constexpr size_t WS_W2T_B = WS_W1T_B + al256((size_t)2 * FF * D * 2);
constexpr size_t WS_WINT = WS_W2T_B + al256((size_t)D * FF * 2);
constexpr size_t WS_WOUTT = WS_WINT + al256((size_t)NINP * D * 2);
constexpr size_t WS_WQT = WS_WOUTT + al256((size_t)D * D * 2);
constexpr size_t WS_WOT = WS_WQT + al256((size_t)D * D * 2);
constexpr size_t WS_WKVT = WS_WOT + al256((size_t)D * D * 2);
constexpr size_t WS_XN = WS_WKVT + al256((size_t)2 * D * D * 2);
constexpr size_t WS_Y = WS_XN + al256((size_t)MTOK * D * 2);
constexpr size_t WS_R1 = WS_Y + al256((size_t)MTOK * D * 4);
constexpr size_t WS_CAT = WS_R1 + al256((size_t)MTOK * FF * 2);
constexpr size_t WS_MEMB = WS_CAT + al256((size_t)MTOK * D * 2);
constexpr size_t WS_KM = WS_MEMB + al256((size_t)MMEM * D * 2);
constexpr size_t WS_VT = WS_KM + al256((size_t)MMEM * D * 2);
constexpr size_t WS_STATS = WS_VT + al256((size_t)MMEM * D * 2);
constexpr size_t WS_PSUM = WS_STATS + al256((size_t)MTOK * 2 * 4);
constexpr size_t WS_HLOC = WS_PSUM + al256((size_t)NB * 4 * SEQ * 4 * 4);
constexpr size_t WS_ACUM = WS_HLOC + al256((size_t)MTOK * WA * 4);
constexpr size_t WS_AEND = WS_ACUM + al256((size_t)MTOK * WA * 4);
constexpr size_t WS_HEND = WS_AEND + al256((size_t)NB * 32 * WA * 4);
constexpr size_t WS_CIN = WS_HEND + al256((size_t)NB * 32 * WA * 4);
constexpr size_t WS_U = WS_CIN + al256((size_t)NB * 32 * WA * 4);
constexpr size_t WS_DEC = WS_U + al256((size_t)NB * 32 * 4 * 4608 * 4);
constexpr size_t WS_BAR = WS_DEC + al256((size_t)NB * 32 * 4 * 48 * 4);
constexpr size_t WS_END = WS_BAR + al256((size_t)3456 * 4);
constexpr size_t R1_P_OFF = (size_t)MTOK * D * 2;

__device__ __forceinline__ float bf2f(bf16_t v) { return __uint_as_float(((unsigned)v) << 16); }
__device__ __forceinline__ unsigned f2bf(float f) { unsigned u = __float_as_uint(f); return (u + 0x7fffu + ((u >> 16) & 1u)) >> 16; }
__device__ __forceinline__ unsigned pk2(float lo, float hi) { return f2bf(lo) | (f2bf(hi) << 16); }
__device__ __forceinline__ float sigmoidf_(float x) { return 1.0f / (1.0f + __expf(-x)); }
__device__ __forceinline__ float siluf_(float x) { return x / (1.0f + __expf(-x)); }
__device__ __forceinline__ float gelu_tanh(float x) { const float u = 0.7978845608028654f * (x + 0.044715f * x * x * x); return 0.5f * x * (1.0f + tanhf(u)); }
__device__ __forceinline__ float wave_sum(float v) {
#pragma unroll
    for (int o = 1; o < 64; o <<= 1) v += __shfl_xor(v, o);
    return v;
}
#define LDS_WAIT() asm volatile("s_waitcnt lgkmcnt(0)" ::: "memory")
__device__ __forceinline__ int otid() { int t = threadIdx.x; asm volatile("" : "+v"(t)); return t; }


#define XB_TMO      128
#define XB_XCNT(j)  (256  + 64 * (j))
#define XB_XSUB(j)  (1280 + 64 * (j))
#define XB_XGEN(j)  (2304 + 64 * (j))
#define XB_TOP      3328
#define XB_TOPGEN   3392
#define XCD_BAR_WORDS 3456
#define XB_SPIN_CAP (1u << 18)
__device__ __forceinline__ unsigned xb_ld(unsigned* p)              { return __hip_atomic_load(p, __ATOMIC_RELAXED, __HIP_MEMORY_SCOPE_AGENT); }
__device__ __forceinline__ unsigned xb_add(unsigned* p, unsigned v) { return __hip_atomic_fetch_add(p, v, __ATOMIC_RELAXED, __HIP_MEMORY_SCOPE_AGENT); }
__device__ __forceinline__ unsigned xb_xcc_id() { return (unsigned)__builtin_amdgcn_s_getreg((3 << 11) | 20) & 0xFu; }
#define XB_SPIN(cond, bar) do { unsigned _sp = 0; while (cond) { __builtin_amdgcn_s_sleep(1); \
    if ((++_sp & 255u) == 0u) { if (xb_ld(&(bar)[XB_TMO])) break; if (_sp > XB_SPIN_CAP) { atomicAdd(&(bar)[XB_TMO], 1u); break; } } } } while (0)
struct XcdBarrier { unsigned* bar; unsigned x; volatile LAS unsigned* st; };
__device__ __forceinline__ XcdBarrier xcd_barrier_post(unsigned* bar, volatile LAS unsigned* st) {
    XcdBarrier b; b.bar = bar; b.x = xb_xcc_id(); b.st = st;
    if (threadIdx.x == 0) (void)xb_add(&bar[XB_XCNT(b.x)], 1u);
    return b;
}
__device__ __forceinline__ void xcd_barrier_complete(unsigned* bar, unsigned x, unsigned& nloc, unsigned& nx) {
    const unsigned G = gridDim.x * gridDim.y * gridDim.z;
    unsigned sum, cnt, mine, sp = 0u;
    for (;;) {
        sum = 0u; cnt = 0u; mine = 0u;
#pragma unroll
        for (unsigned j = 0; j < 16; ++j) { const unsigned c = xb_ld(&bar[XB_XCNT(j)]); sum += c; cnt += (c > 0u) ? 1u : 0u; mine = (j == x) ? c : mine; }
        if (sum == G) break;
        __builtin_amdgcn_s_sleep(1);
        if ((++sp & 255u) == 0u) { if (xb_ld(&bar[XB_TMO])) break; if (sp > XB_SPIN_CAP) { atomicAdd(&bar[XB_TMO], 1u); break; } }
    }
    nloc = mine > 0u ? mine : 1u; nx = cnt > 0u ? cnt : 1u;
}
__device__ __forceinline__ void xcd_barrier(const XcdBarrier& b) {
    asm volatile("s_waitcnt vmcnt(0)" ::: "memory");
    __syncthreads();
    if (threadIdx.x == 0) {
        unsigned* bar = b.bar;
        __builtin_amdgcn_s_waitcnt(0);
        unsigned nloc = b.st[0], nx = b.st[1];
        if (nloc == 0u) { xcd_barrier_complete(bar, b.x, nloc, nx); b.st[0] = nloc; b.st[1] = nx; }
        const unsigned old = xb_add(&bar[XB_XSUB(b.x)], 1u);
        const unsigned gen = old / nloc;
        if (old + 1u == (gen + 1u) * nloc) {
            __builtin_amdgcn_fence(__ATOMIC_RELEASE, "agent");
            asm volatile("s_waitcnt vmcnt(0)" ::: "memory");
            const unsigned og = xb_add(&bar[XB_TOP], 1u);
            const unsigned tg = og / nx;
            if (og + 1u == (tg + 1u) * nx) xb_add(&bar[XB_TOPGEN], 1u);
            else XB_SPIN(xb_ld(&bar[XB_TOPGEN]) == tg, bar);
            __builtin_amdgcn_fence(__ATOMIC_ACQUIRE, "agent");
            xb_add(&bar[XB_XGEN(b.x)], 1u);
            asm volatile("s_waitcnt vmcnt(0)" ::: "memory");
        } else {
            XB_SPIN(xb_ld(&bar[XB_XGEN(b.x)]) == gen, bar);
            __builtin_amdgcn_fence(__ATOMIC_ACQUIRE, "agent");
            asm volatile("s_waitcnt vmcnt(0)" ::: "memory");
        }
    }
    __syncthreads();
}

constexpr int BM = 256, BK = 64, HALF = 128, HTB = HALF * BK * 2, NXCD = 8, WGM = 8;
__device__ __forceinline__ int lds_byte(int r, int c) { const int st = (r >> 4) * 2 + (c >> 5), rr = r & 15, cc = c & 31, ob = rr * 64 + cc * 2; return st * 1024 + (ob ^ (((ob >> 9) & 1) << 5)); }
__device__ __forceinline__ void stage_rc(int b, int& R, int& C) { const int st = b / 1024, sb = b % 1024, swz = sb ^ (((sb >> 9) & 1) << 5); R = (st >> 1) * 16 + swz / 64; C = (st & 1) * 32 + (swz % 64) / 2; }
__device__ __forceinline__ int perm32(int rho) { const int n = rho >> 4, i = rho & 15; return 8 * (i >> 2) + 4 * n + (i & 3); }

struct Unit { int pm, pn; };

struct StdProb {
    const bf16_t* A; const bf16_t* Bt; int lda, ldb, K;
    int nM, nN, nwg, G, c;
    __device__ __forceinline__ void init(const bf16_t* A_, const bf16_t* Bt_, int lda_, int ldb_, int K_, int M_, int N_, int G_, int c_) {
        A = A_; Bt = Bt_; lda = lda_; ldb = ldb_; K = K_; nM = M_ / BM; nN = N_ / BM; nwg = nM * nN; G = G_; c = c_; }
    __device__ __forceinline__ bool next(int i, Unit& u) const {
        const long L = (long)i * G + c; if (L >= nwg) return false;
        int wgid = (int)L; { const int q = nwg / NXCD, r = nwg % NXCD, xcd = wgid % NXCD, off = wgid / NXCD; wgid = (xcd < r ? xcd * (q + 1) : r * (q + 1) + (xcd - r) * q) + off; }
        const int nig = WGM * nN, gid = wgid / nig, fm = gid * WGM, gsz = (nM - fm) < WGM ? (nM - fm) : WGM;
        u.pm = fm + ((wgid % nig) % gsz); u.pn = (wgid % nig) / gsz; return true;
    }
    __device__ __forceinline__ const char* aptr(const Unit& u) const { return (const char*)(A + (size_t)u.pm * BM * lda); }
    __device__ __forceinline__ const char* bptr(const Unit& u) const { return (const char*)(Bt + (size_t)u.pn * BM * ldb); }
};
struct ScoreProb {
    const bf16_t* Q; const bf16_t* Km; int lda, ldb, K; int G, c;
    __device__ __forceinline__ bool next(int i, Unit& u) const { const long L = (long)i * G + c; if (L >= 256) return false; u.pm = (int)L; u.pn = 0; return true; }
    __device__ __forceinline__ const char* aptr(const Unit& u) const { const int b = u.pm >> 5, h = (u.pm >> 3) & 3, mt = u.pm & 7; return (const char*)(Q + ((size_t)(b * SEQ + mt * 256) * D + h * 256)); }
    __device__ __forceinline__ const char* bptr(const Unit& u) const { const int b = u.pm >> 5, h = (u.pm >> 3) & 3; return (const char*)(Km + ((size_t)(b * MEML) * D + h * 256)); }
};
struct PVProb {
    const bf16_t* P; const bf16_t* VT; int lda, ldb, K; int G, c;
    __device__ __forceinline__ bool next(int i, Unit& u) const { const long L = (long)i * G + c; if (L >= 256) return false; u.pm = (int)L; u.pn = 0; return true; }
    __device__ __forceinline__ const char* aptr(const Unit& u) const { return (const char*)(P + (size_t)u.pm * 256 * 256); }
    __device__ __forceinline__ const char* bptr(const Unit& u) const { const int b = u.pm >> 5, h = (u.pm >> 3) & 3; return (const char*)(VT + ((size_t)(h * 256) * MMEM + b * MEML)); }
};

struct EpiSwiGLU {
    static constexpr bool PERM = true;
    bf16_t* H;
    __device__ __forceinline__ void operator()(const f32x4 (&acc)[2][2][4][2], const Unit& u, int wr, int wc, int fr, int fq) const {
        const int row0 = u.pm * BM + wr * 64 + fr, col0 = u.pn * 128 + wc * 32 + 8 * fq;
#pragma unroll
        for (int ai = 0; ai < 2; ++ai)
#pragma unroll
            for (int m = 0; m < 4; ++m) {
                bf16_t* rowp = H + (size_t)(row0 + ai * HALF + m * 16) * FF + col0;
                const f32x4 g0 = acc[ai][0][m][0], g1 = acc[ai][0][m][1], u0 = acc[ai][1][m][0], u1 = acc[ai][1][m][1];
                u32x4 w;
                w.x = pk2(siluf_(g0[0]) * u0[0], siluf_(g0[1]) * u0[1]); w.y = pk2(siluf_(g0[2]) * u0[2], siluf_(g0[3]) * u0[3]);
                w.z = pk2(siluf_(g1[0]) * u1[0], siluf_(g1[1]) * u1[1]); w.w = pk2(siluf_(g1[2]) * u1[2], siluf_(g1[3]) * u1[3]);
                *(u32x4*)rowp = w;
            }
    }
};
struct EpiBf16 {
    static constexpr bool PERM = true;
    bf16_t* O; int ldc; float scale;
    __device__ __forceinline__ void operator()(const f32x4 (&acc)[2][2][4][2], const Unit& u, int wr, int wc, int fr, int fq) const {
        const int row0 = u.pm * BM + wr * 64 + fr, col0 = u.pn * BM + wc * 32 + 8 * fq;
#pragma unroll
        for (int ai = 0; ai < 2; ++ai)
#pragma unroll
            for (int m = 0; m < 4; ++m) {
                bf16_t* rowp = O + (size_t)(row0 + ai * HALF + m * 16) * ldc + col0;
#pragma unroll
                for (int bj = 0; bj < 2; ++bj) {
                    const f32x4 v0 = acc[ai][bj][m][0] * scale, v1 = acc[ai][bj][m][1] * scale;
                    u32x4 w; w.x = pk2(v0[0], v0[1]); w.y = pk2(v0[2], v0[3]); w.z = pk2(v1[0], v1[1]); w.w = pk2(v1[2], v1[3]);
                    *(u32x4*)(rowp + bj * HALF) = w;
                }
            }
    }
};
struct EpiRes {
    static constexpr bool PERM = false;
    float* Y; const float* Xin; const float* stats; const float* g; const float* b; float scale;
    __device__ __forceinline__ void operator()(const f32x4 (&acc)[2][2][4][2], const Unit& u, int wr, int wc, int fr, int fq) const {
        const int row0 = u.pm * BM + wr * 64 + fr, col0 = u.pn * BM + wc * 32 + 4 * fq;
        f32x4 gv[2][2], bv[2][2];
#pragma unroll
        for (int bj = 0; bj < 2; ++bj)
#pragma unroll
            for (int n = 0; n < 2; ++n) { gv[bj][n] = *(const f32x4*)(g + col0 + bj * HALF + n * 16); bv[bj][n] = *(const f32x4*)(b + col0 + bj * HALF + n * 16); }
#pragma unroll
        for (int ai = 0; ai < 2; ++ai)
#pragma unroll
            for (int m = 0; m < 4; ++m) {
                const int row = row0 + ai * HALF + m * 16;
                const float mean = stats[2 * row], rstd = stats[2 * row + 1];
                float* rowp = Y + (size_t)row * D + col0;
                const float* xrow = Xin ? (Xin + (size_t)row * D + col0) : rowp;
#pragma unroll
                for (int bj = 0; bj < 2; ++bj)
#pragma unroll
                    for (int n = 0; n < 2; ++n) {
                        f32x4 xv = *(const f32x4*)(xrow + bj * HALF + n * 16);
                        if (!Xin) xv = (xv - mean) * rstd * gv[bj][n] + bv[bj][n];
                        *(f32x4*)(rowp + bj * HALF + n * 16) = xv * ALPHA + acc[ai][bj][m][n] * scale;
                    }
            }
    }
};
struct EpiExp {
    static constexpr bool PERM = true;
    bf16_t* P; float* psum;
    __device__ __forceinline__ void operator()(const f32x4 (&acc)[2][2][4][2], const Unit& u, int wr, int wc, int fr, int fq) const {
        const int row0 = u.pm * BM + wr * 64 + fr, col0 = wc * 32 + 8 * fq;
#pragma unroll
        for (int ai = 0; ai < 2; ++ai)
#pragma unroll
            for (int m = 0; m < 4; ++m) {
                const int row = row0 + ai * HALF + m * 16;
                bf16_t* rowp = P + (size_t)row * 256 + col0;
                float s = 0.f;
#pragma unroll
                for (int bj = 0; bj < 2; ++bj) {
                    unsigned e[8];
#pragma unroll
                    for (int j = 0; j < 4; ++j) { e[j] = f2bf(__expf(fminf(acc[ai][bj][m][0][j], 80.f))); e[4 + j] = f2bf(__expf(fminf(acc[ai][bj][m][1][j], 80.f))); }
#pragma unroll
                    for (int j = 0; j < 8; ++j) s += __uint_as_float(e[j] << 16);
                    u32x4 w; w.x = e[0] | (e[1] << 16); w.y = e[2] | (e[3] << 16); w.z = e[4] | (e[5] << 16); w.w = e[6] | (e[7] << 16);
                    *(u32x4*)(rowp + bj * HALF) = w;
                }
                s += __shfl_xor(s, 16); s += __shfl_xor(s, 32);
                if (fq == 0) psum[(size_t)row * 4 + wc] = s;
            }
    }
};
struct EpiPV {
    static constexpr bool PERM = true;
    bf16_t* O; const float* psum;
    __device__ __forceinline__ void operator()(const f32x4 (&acc)[2][2][4][2], const Unit& u, int wr, int wc, int fr, int fq) const {
        const int b = u.pm >> 5, h = (u.pm >> 3) & 3, mt = u.pm & 7;
        const int rl0 = wr * 64 + fr, col0 = h * 256 + wc * 32 + 8 * fq;
#pragma unroll
        for (int ai = 0; ai < 2; ++ai)
#pragma unroll
            for (int m = 0; m < 4; ++m) {
                int rl = rl0 + ai * HALF + m * 16; asm volatile("" : "+v"(rl));
                const f32x4 ps = *(const f32x4*)(psum + ((size_t)u.pm * 256 + rl) * 4);
                const float inv = 1.0f / ((ps[0] + ps[1]) + (ps[2] + ps[3]));
                bf16_t* rowp = O + (size_t)(b * SEQ + mt * 256 + rl) * D + col0;
#pragma unroll
                for (int bj = 0; bj < 2; ++bj) {
                    const f32x4 v0 = acc[ai][bj][m][0] * inv, v1 = acc[ai][bj][m][1] * inv;
                    u32x4 w; w.x = pk2(v0[0], v0[1]); w.y = pk2(v0[2], v0[3]); w.z = pk2(v1[0], v1[1]); w.w = pk2(v1[2], v1[3]);
                    *(u32x4*)(rowp + bj * HALF) = w;
                }
                __builtin_amdgcn_sched_barrier(0);
            }
    }
};

template <class Prob, class Epi>
__device__ __forceinline__ void gemm_phase(LAS unsigned char* lds, const Prob& S, const Epi& E) {
    const int tid = otid(), wid = __builtin_amdgcn_readfirstlane(tid >> 6), lane = tid & 63, wr = wid >> 2, wc = wid & 3, fr = lane & 15, fq = lane >> 4;
    const int K = S.K, nt = K / BK, lda = S.lda, ldb = S.ldb;
    unsigned voffA[2], voffB[2];
#pragma unroll
    for (int i = 0; i < 2; ++i) { int R, C; stage_rc(tid * 16 + i * 8192, R, C); const int Rb = Epi::PERM ? ((R & ~31) + perm32(R & 31)) : R;
        voffA[i] = (unsigned)(R * lda + C) * 2u; voffB[i] = (unsigned)(Rb * ldb + C) * 2u; }
    const size_t kstep = (size_t)(BK * 2);
    const size_t hA = (size_t)HALF * lda * 2, hB = (size_t)HALF * ldb * 2;
    const unsigned ldsw = (unsigned)wid * 1024u;
    const int aoff = lds_byte(wr * 64 + fr, fq * 8), boff = lds_byte(wc * 32 + fr, fq * 8);
#define PG8_SA(b, h) (((b) * 2 + (h)) * HTB)
#define PG8_SB(b, h) ((4 + (b) * 2 + (h)) * HTB)
#define PG8_STAGE(bufoff, gbase, voff) do { _Pragma("unroll") for (int _i = 0; _i < 2; ++_i) \
        __builtin_amdgcn_global_load_lds((const unsigned*)((const char*)(gbase) + (voff)[_i]), (LAS unsigned*)(lds + (bufoff) + ldsw + _i * 8192), 16, 0, 0); } while (0)
#define PG8_LDA(dst, b, h) do { _Pragma("unroll") for (int m = 0; m < 4; ++m) _Pragma("unroll") for (int k = 0; k < 2; ++k) dst[m][k] = *(const LAS bf16x8*)(lds + PG8_SA(b, h) + aoff + m * 2048 + k * 1024); } while (0)
#define PG8_LDB(dst, b, h) do { _Pragma("unroll") for (int n = 0; n < 2; ++n) _Pragma("unroll") for (int k = 0; k < 2; ++k) dst[n][k] = *(const LAS bf16x8*)(lds + PG8_SB(b, h) + boff + n * 2048 + k * 1024); } while (0)
#define PG8_MMA(ai, bj, At, Bt) do { __builtin_amdgcn_s_setprio(1); _Pragma("unroll") for (int m = 0; m < 4; ++m) _Pragma("unroll") for (int n = 0; n < 2; ++n) _Pragma("unroll") for (int k = 0; k < 2; ++k) \
        acc[ai][bj][m][n] = __builtin_amdgcn_mfma_f32_16x16x32_bf16(Bt[n][k], At[m][k], acc[ai][bj][m][n], 0, 0, 0); __builtin_amdgcn_s_setprio(0); } while (0)
#define PG8_WAIT_V(n) asm volatile("s_waitcnt vmcnt(" #n ")" ::: "memory")
#define PG8_WAIT_L(n) asm volatile("s_waitcnt lgkmcnt(" #n ")" ::: "memory")
#define PG8_BAR __builtin_amdgcn_s_barrier()
#define PG8_SCHED __builtin_amdgcn_sched_barrier(0)
    Unit cur, nxt; int ui = 0;
    if (!S.next(0, cur)) return;
    f32x4 acc[2][2][4][2];
#pragma unroll
    for (int a = 0; a < 2; ++a)
#pragma unroll
        for (int b = 0; b < 2; ++b)
#pragma unroll
            for (int m = 0; m < 4; ++m)
#pragma unroll
                for (int n = 0; n < 2; ++n) acc[a][b][m][n] = (f32x4){0.f, 0.f, 0.f, 0.f};
    bf16x8 At[4][2], B0[2][2], B1[2][2];
    const char* cA = S.aptr(cur); const char* cB = S.bptr(cur);
    PG8_STAGE(PG8_SB(0, 0), cB, voffB); PG8_STAGE(PG8_SA(0, 0), cA, voffA); PG8_STAGE(PG8_SB(0, 1), cB + hB, voffB); PG8_STAGE(PG8_SA(0, 1), cA + hA, voffA);
    if (wr == 1) PG8_BAR;
    PG8_WAIT_V(4); PG8_BAR;
    PG8_STAGE(PG8_SB(1, 0), cB + kstep, voffB); PG8_STAGE(PG8_SA(1, 0), cA + kstep, voffA); PG8_STAGE(PG8_SB(1, 1), cB + hB + kstep, voffB);
    PG8_WAIT_V(6); PG8_BAR;
    for (;;) {
        const bool has_next = S.next(ui + 1, nxt);
        const char* nA = has_next ? S.aptr(nxt) : cA; const char* nB = has_next ? S.bptr(nxt) : cB;
        for (int t = 0; t < nt; t += 2) {
            const bool last = (t == nt - 2);
            const char* a1 = cA + (size_t)(t + 1) * kstep;
            const char* a2 = last ? nA : cA + (size_t)(t + 2) * kstep; const char* b2 = last ? nB : cB + (size_t)(t + 2) * kstep;
            const char* a3 = a2 + kstep; const char* b3 = b2 + kstep;
            PG8_LDB(B0, 0, 0); PG8_SCHED; PG8_LDA(At, 0, 0); PG8_STAGE(PG8_SA(1, 1), a1 + hA, voffA);
            PG8_WAIT_L(8); PG8_BAR; PG8_WAIT_L(0); PG8_MMA(0, 0, At, B0); PG8_BAR; PG8_SCHED;
            PG8_LDB(B1, 0, 1); PG8_STAGE(PG8_SB(0, 0), b2, voffB);
            PG8_BAR; PG8_WAIT_L(0); PG8_MMA(0, 1, At, B1); PG8_BAR;
            PG8_LDA(At, 0, 1); PG8_STAGE(PG8_SA(0, 0), a2, voffA);
            PG8_BAR; PG8_WAIT_L(0); PG8_MMA(1, 0, At, B0); PG8_BAR; PG8_SCHED;
            PG8_STAGE(PG8_SB(0, 1), b2 + hB, voffB);
            PG8_WAIT_V(6); PG8_BAR; PG8_MMA(1, 1, At, B1); PG8_BAR;
            PG8_LDB(B0, 1, 0); PG8_SCHED; PG8_LDA(At, 1, 0); PG8_STAGE(PG8_SA(0, 1), a2 + hA, voffA);
            PG8_WAIT_L(8); PG8_BAR; PG8_WAIT_L(0); PG8_MMA(0, 0, At, B0); PG8_BAR; PG8_SCHED;
            PG8_LDB(B1, 1, 1); PG8_STAGE(PG8_SB(1, 0), b3, voffB);
            PG8_BAR; PG8_WAIT_L(0); PG8_MMA(0, 1, At, B1); PG8_BAR;
            PG8_LDA(At, 1, 1); PG8_STAGE(PG8_SA(1, 0), a3, voffA);
            PG8_BAR; PG8_WAIT_L(0); PG8_MMA(1, 0, At, B0); PG8_BAR; PG8_SCHED;
            PG8_STAGE(PG8_SB(1, 1), b3 + hB, voffB);
            PG8_WAIT_V(6); PG8_BAR; PG8_MMA(1, 1, At, B1); PG8_BAR;
        }
        E(acc, cur, wr, wc, fr, fq);
        if (!has_next) break;
#pragma unroll
        for (int a = 0; a < 2; ++a)
#pragma unroll
            for (int b = 0; b < 2; ++b)
#pragma unroll
                for (int m = 0; m < 4; ++m)
#pragma unroll
                    for (int n = 0; n < 2; ++n) acc[a][b][m][n] = (f32x4){0.f, 0.f, 0.f, 0.f};
        cur = nxt; cA = nA; cB = nB; ++ui;
    }
    PG8_WAIT_V(0);
    if (wr == 0) PG8_BAR;
    PG8_BAR;
#undef PG8_SA
#undef PG8_SB
#undef PG8_STAGE
#undef PG8_LDA
#undef PG8_LDB
#undef PG8_MMA
#undef PG8_WAIT_V
#undef PG8_WAIT_L
#undef PG8_BAR
#undef PG8_SCHED
}

struct Args { const float* in[33]; float* out; unsigned char* ws; int ph_lo, ph_hi; };
typedef const Args __attribute__((address_space(4))) KArgs;
enum { I_X = 0, I_MEM, I_F1IN, I_F1OUT, I_LN1G, I_LN1B, I_MIXIN, I_RGCW, I_RGCB, I_RGWR, I_RGBR, I_RGWI, I_RGBI, I_RGLAM, I_GLAWG, I_GLABG, I_GLANG,
       I_CVW, I_CVB, I_CVGG, I_CVGB, I_MIXOUT, I_LN2G, I_LN2B, I_XAQ, I_XAKV, I_XAO, I_LN3G, I_LN3B, I_F2IN, I_F2OUT, I_LN4G, I_LN4B };

__device__ __forceinline__ void transpose_item(const float* W, int K, int Nsrc, int k0, int n0, bf16_t* WT, int drow0, LAS float* scr, int lane) {
    const int col = n0 + (lane & 31); const bool ok = col < Nsrc;
#pragma unroll 8
    for (int i = 0; i < 32; ++i) { const int kk = 2 * i + (lane >> 5); scr[kk * 33 + (lane & 31)] = ok ? W[(size_t)(k0 + kk) * Nsrc + col] : 0.f; }
    LDS_WAIT();
    const int c = lane & 7;
#pragma unroll
    for (int j = 0; j < 4; ++j) { const int n = (lane >> 3) + 8 * j; const LAS float* s = scr + (8 * c) * 33 + n;
        u32x4 o; o.x = pk2(s[0 * 33], s[1 * 33]); o.y = pk2(s[2 * 33], s[3 * 33]); o.z = pk2(s[4 * 33], s[5 * 33]); o.w = pk2(s[6 * 33], s[7 * 33]);
        *(u32x4*)(WT + (size_t)(drow0 + n) * K + k0 + 8 * c) = o; }
    LDS_WAIT();
}
__device__ __forceinline__ int w1_row(int n0) { const int up = n0 >= FF ? 1 : 0, j = n0 - up * FF; return 256 * (j >> 7) + 128 * up + (j & 127); }

__device__ __forceinline__ void convert_weights(KArgs& a, int l, LAS unsigned char* lds) {
    const int tid_ = otid(); const int lane = tid_ & 63, wave = tid_ >> 6;
    LAS float* scr = (LAS float*)(lds + wave * 16384);
    const int gw = blockIdx.x * 8 + wave, NGW = gridDim.x * 8;
    unsigned char* ws = a.ws;
    constexpr int I_1 = (D / 64) * (2 * FF / 32), I_2 = (FF / 64) * (D / 32), I_IN = (D / 64) * (NINP / 32), I_SQ = (D / 64) * (D / 32), I_KV = (D / 64) * (2 * D / 32);
    constexpr int NITEMS = 2 * I_1 + 2 * I_2 + I_IN + 3 * I_SQ + I_KV;
    for (int it = gw; it < NITEMS; it += NGW) {
        int r = it;
        if (r < I_1) { const int nb = 2 * FF / 32, kb = r / nb, n0 = (r % nb) * 32; transpose_item(a.in[I_F1IN] + (size_t)l * D * 2 * FF, D, 2 * FF, kb * 64, n0, (bf16_t*)(ws + WS_W1T_A), w1_row(n0), scr, lane); continue; } r -= I_1;
        if (r < I_1) { const int nb = 2 * FF / 32, kb = r / nb, n0 = (r % nb) * 32; transpose_item(a.in[I_F2IN] + (size_t)l * D * 2 * FF, D, 2 * FF, kb * 64, n0, (bf16_t*)(ws + WS_W1T_B), w1_row(n0), scr, lane); continue; } r -= I_1;
        if (r < I_2) { const int nb = D / 32, kb = r / nb, n0 = (r % nb) * 32; transpose_item(a.in[I_F1OUT] + (size_t)l * FF * D, FF, D, kb * 64, n0, (bf16_t*)(ws + WS_W2T_A), n0, scr, lane); continue; } r -= I_2;
        if (r < I_2) { const int nb = D / 32, kb = r / nb, n0 = (r % nb) * 32; transpose_item(a.in[I_F2OUT] + (size_t)l * FF * D, FF, D, kb * 64, n0, (bf16_t*)(ws + WS_W2T_B), n0, scr, lane); continue; } r -= I_2;
        if (r < I_IN) { const int nb = NINP / 32, kb = r / nb, n0 = (r % nb) * 32; transpose_item(a.in[I_MIXIN] + (size_t)l * D * NIN, D, NIN, kb * 64, n0, (bf16_t*)(ws + WS_WINT), n0, scr, lane); continue; } r -= I_IN;
        if (r < I_SQ) { const int nb = D / 32, kb = r / nb, n0 = (r % nb) * 32; transpose_item(a.in[I_MIXOUT] + (size_t)l * D * D, D, D, kb * 64, n0, (bf16_t*)(ws + WS_WOUTT), n0, scr, lane); continue; } r -= I_SQ;
        if (r < I_SQ) { const int nb = D / 32, kb = r / nb, n0 = (r % nb) * 32; transpose_item(a.in[I_XAQ] + (size_t)l * D * D, D, D, kb * 64, n0, (bf16_t*)(ws + WS_WQT), n0, scr, lane); continue; } r -= I_SQ;
        if (r < I_SQ) { const int nb = D / 32, kb = r / nb, n0 = (r % nb) * 32; transpose_item(a.in[I_XAO] + (size_t)l * D * D, D, D, kb * 64, n0, (bf16_t*)(ws + WS_WOT), n0, scr, lane); continue; } r -= I_SQ;
        { const int nb = 2 * D / 32, kb = r / nb, n0 = (r % nb) * 32; transpose_item(a.in[I_XAKV] + (size_t)l * D * 2 * D, D, 2 * D, kb * 64, n0, (bf16_t*)(ws + WS_WKVT), n0, scr, lane); }
    }
}
__device__ __forceinline__ void cvt_rows(const float* src, bf16_t* dst, size_t n) {
    const size_t g = (size_t)blockIdx.x * NTHREADS + otid(), NT = (size_t)gridDim.x * NTHREADS;
    for (size_t i = g; i < n / 4; i += NT) { const f32x4 v = ((const f32x4*)src)[i]; u32x2 o; o.x = pk2(v[0], v[1]); o.y = pk2(v[2], v[3]); ((u32x2*)dst)[i] = o; }
}
__device__ __forceinline__ void ln_phase(const float* Y, const float* g, const float* b, bf16_t* XN, float* stats, float* out) {
    const int tid_ = otid(); const int lane = tid_ & 63, wave = tid_ >> 6;
    const int gw = blockIdx.x * 8 + wave, NGW = gridDim.x * 8;
    f32x4 gv[4], bv[4];
#pragma unroll
    for (int j = 0; j < 4; ++j) { gv[j] = ((const f32x4*)g)[64 * j + lane]; bv[j] = ((const f32x4*)b)[64 * j + lane]; }
    for (int row = gw; row < MTOK; row += NGW) {
        const f32x4* xr = (const f32x4*)(Y + (size_t)row * D) + lane;
        f32x4 v[4]; float s = 0.f;
#pragma unroll
        for (int j = 0; j < 4; ++j) { v[j] = xr[64 * j]; s += (v[j][0] + v[j][1]) + (v[j][2] + v[j][3]); }
        const float mean = wave_sum(s) * (1.f / D); float s2 = 0.f;
#pragma unroll
        for (int j = 0; j < 4; ++j) { const f32x4 d = v[j] - mean; s2 += (d[0] * d[0] + d[1] * d[1]) + (d[2] * d[2] + d[3] * d[3]); }
        const float rstd = 1.0f / sqrtf(wave_sum(s2) * (1.f / D) + EPS);
        if (lane == 0) { stats[2 * row] = mean; stats[2 * row + 1] = rstd; }
        u32x2* o8 = (u32x2*)(XN + (size_t)row * D) + lane;
#pragma unroll
        for (int j = 0; j < 4; ++j) {
            const f32x4 o = (v[j] - mean) * rstd * gv[j] + bv[j];
            u32x2 w; w.x = pk2(o[0], o[1]); w.y = pk2(o[2], o[3]); o8[64 * j] = w;
            if (out) ((f32x4*)(out + (size_t)row * D))[64 * j + lane] = o;
        }
    }
}

__device__ __forceinline__ void rg_local(KArgs& a, int l, int item, LAS float* L) {
    const int tid = otid();
    const int hd = item % 6, bn = item / 6, b = bn >> 5, n = bn & 31, t0 = n * 64, tokbase = b * SEQ;
    const bf16_t* PROJ = (const bf16_t*)(a.ws + WS_R1);
    LAS float* xa_s = L; LAS float* xc_s = L + 4288; LAS float* wr_s = L + 8448; LAS float* wi_s = L + 12544; LAS float* a_s = L + 16640; LAS float* u_s = L + 20736;
    for (int e = tid; e < 67 * 64; e += NTHREADS) { const int r = e >> 6, c = e & 63, s = t0 - 3 + r;
        xa_s[e] = s >= 0 ? bf2f(PROJ[(size_t)(tokbase + s) * NINP + C_XA + hd * 64 + c]) : 0.f; }
    { const float* wr = a.in[I_RGWR] + (size_t)(l * 6 + hd) * 4096; const float* wi = a.in[I_RGWI] + (size_t)(l * 6 + hd) * 4096;
      for (int e = tid; e < 4096; e += NTHREADS) { wr_s[e] = wr[e]; wi_s[e] = wi[e]; } }
    __syncthreads();
    { const float* cw = a.in[I_RGCW] + (size_t)l * 4 * WA; const float* cb = a.in[I_RGCB] + (size_t)l * WA;
      for (int e = tid; e < 4096; e += NTHREADS) { const int t = e >> 6, c = e & 63, ch = hd * 64 + c; float acc = cb[ch];
#pragma unroll
          for (int k = 0; k < 4; ++k) acc += cw[k * WA + ch] * xa_s[(t + k) * 64 + c];
          xc_s[t * 65 + c] = acc; } }
    __syncthreads();
    { const int t = tid >> 3, jg = tid & 7;
      float racc[8], iacc[8];
#pragma unroll
      for (int j = 0; j < 8; ++j) { racc[j] = 0.f; iacc[j] = 0.f; }
      for (int i = 0; i < 64; ++i) {
          const float x = xc_s[t * 65 + i];
          const f32x4 r0 = *(const LAS f32x4*)(wr_s + i * 64 + jg * 8), r1 = *(const LAS f32x4*)(wr_s + i * 64 + jg * 8 + 4);
          const f32x4 i0 = *(const LAS f32x4*)(wi_s + i * 64 + jg * 8), i1 = *(const LAS f32x4*)(wi_s + i * 64 + jg * 8 + 4);
#pragma unroll
          for (int j = 0; j < 4; ++j) { racc[j] += x * r0[j]; racc[4 + j] += x * r1[j]; iacc[j] += x * i0[j]; iacc[4 + j] += x * i1[j]; }
      }
      const float* br = a.in[I_RGBR] + (size_t)l * WA + hd * 64; const float* bi = a.in[I_RGBI] + (size_t)l * WA + hd * 64; const float* lam = a.in[I_RGLAM] + (size_t)l * WA + hd * 64;
#pragma unroll
      for (int jj = 0; jj < 8; ++jj) { const int j = jg * 8 + jj;
          const float r = sigmoidf_(racc[jj] + br[j]), ig = sigmoidf_(iacc[jj] + bi[j]);
          const float z = -lam[j]; const float sp = fmaxf(z, 0.f) + log1pf(__expf(-fabsf(z)));
          const float log_a = -8.0f * r * sp; const float av = __expf(log_a);
          const float uv = sqrtf(-expm1f(2.0f * log_a)) * (ig * xc_s[t * 65 + j]);
          a_s[t * 64 + j] = av; u_s[t * 64 + j] = uv; }
    }
    __syncthreads();
    if (tid < 64) { const int c = tid; float H = 0.f, P = 1.f;
        float* HLOC = (float*)(a.ws + WS_HLOC); float* ACUM = (float*)(a.ws + WS_ACUM);
        for (int t = 0; t < 64; ++t) { const float av = a_s[t * 64 + c]; H = av * H + u_s[t * 64 + c]; P *= av;
            const size_t idx = (size_t)(tokbase + t0 + t) * WA + hd * 64 + c; HLOC[idx] = H; ACUM[idx] = P; }
        ((float*)(a.ws + WS_AEND))[(size_t)bn * WA + hd * 64 + c] = P; ((float*)(a.ws + WS_HEND))[(size_t)bn * WA + hd * 64 + c] = H; }
    __syncthreads();
}
__device__ __forceinline__ void gla_bcum(KArgs& a, int l, int tok0, int h, LAS float* lr_s, LAS float* wg_s, LAS float* bg_s, LAS float* bc_s) {
    const int tid = otid();
    const bf16_t* PROJ = (const bf16_t*)(a.ws + WS_R1);
    for (int e = tid; e < 1024; e += NTHREADS) { const int t = e >> 4, r = e & 15; lr_s[e] = bf2f(PROJ[(size_t)(tok0 + t) * NINP + C_LR + r]); }
    for (int e = tid; e < 768; e += NTHREADS) { const int r = e / 48, d = e % 48; wg_s[e] = a.in[I_GLAWG][(size_t)(l * 16 + r) * 192 + h * 48 + d]; }
    if (tid < 48) bg_s[tid] = a.in[I_GLABG][(size_t)l * 192 + h * 48 + tid];
    __syncthreads();
    for (int e = tid; e < 3072; e += NTHREADS) { const int t = e / 48, d = e % 48; float acc = bg_s[d];
#pragma unroll
        for (int r = 0; r < 16; ++r) acc += lr_s[t * 16 + r] * wg_s[r * 48 + d];
        const float ls = fminf(acc, 0.f) - log1pf(__expf(-fabsf(acc)));
        bc_s[e] = ls * (1.0f / 16.0f); }
    __syncthreads();
    if (tid < 48) { float s = 0.f; for (int t = 0; t < 64; ++t) { s += bc_s[t * 48 + tid]; bc_s[t * 48 + tid] = s; } }
    __syncthreads();
}
__device__ __forceinline__ void gla1(KArgs& a, int l, int item, LAS float* L) {
    const int tid = otid();
    const int h = item & 3, bn = item >> 2, b = bn >> 5, n = bn & 31, tok0 = b * SEQ + n * 64;
    const bf16_t* PROJ = (const bf16_t*)(a.ws + WS_R1);
    LAS float* lr_s = L; LAS float* wg_s = L + 1024; LAS float* bg_s = L + 1792; LAS float* bc_s = L + 1856; LAS float* k_s = L + 4928; LAS float* v_s = L + 8000;
    for (int e = tid; e < 3072; e += NTHREADS) { const int t = e / 48, d = e % 48; k_s[e] = bf2f(PROJ[(size_t)(tok0 + t) * NINP + C_K + h * 48 + d]); }
    for (int e = tid; e < 6144; e += NTHREADS) { const int t = e / 96, c = e % 96; v_s[e] = bf2f(PROJ[(size_t)(tok0 + t) * NINP + C_V + h * 96 + c]); }
    gla_bcum(a, l, tok0, h, lr_s, wg_s, bg_s, bc_s);
    for (int e = tid; e < 3072; e += NTHREADS) { const int d = e % 48; k_s[e] *= __expf(bc_s[63 * 48 + d] - bc_s[e]); }
    __syncthreads();
    { const int dg = tid >> 5, eg = tid & 31; float acc[3][3];
#pragma unroll
      for (int x = 0; x < 3; ++x)
#pragma unroll
          for (int y = 0; y < 3; ++y) acc[x][y] = 0.f;
      for (int t = 0; t < 64; ++t) { float kv[3], vv[3];
#pragma unroll
          for (int x = 0; x < 3; ++x) { kv[x] = k_s[t * 48 + dg + 16 * x]; vv[x] = v_s[t * 96 + eg + 32 * x]; }
#pragma unroll
          for (int x = 0; x < 3; ++x)
#pragma unroll
              for (int y = 0; y < 3; ++y) acc[x][y] += kv[x] * vv[y]; }
      float* U = (float*)(a.ws + WS_U) + (size_t)(bn * 4 + h) * 4608;
#pragma unroll
      for (int x = 0; x < 3; ++x)
#pragma unroll
          for (int y = 0; y < 3; ++y) U[(dg + 16 * x) * 96 + eg + 32 * y] = acc[x][y];
      if (tid < 48) ((float*)(a.ws + WS_DEC))[(size_t)(bn * 4 + h) * 48 + tid] = __expf(bc_s[63 * 48 + tid]);
    }
    __syncthreads();
}
__device__ __forceinline__ void conv_item(KArgs& a, int l, int item, LAS float* L) {
    const int tid = otid();
    const int b = item >> 6, ck = item & 63, t0 = ck * 32, tokbase = b * SEQ;
    const bf16_t* PROJ = (const bf16_t*)(a.ws + WS_R1);
    bf16_t* CAT = (bf16_t*)(a.ws + WS_CAT);
    for (int e = tid; e < 62 * 256; e += NTHREADS) { const int r = e >> 8, c = e & 255, s = t0 - 30 + r; float v = 0.f;
        if (s >= 0) { const bf16_t* p = PROJ + (size_t)(tokbase + s) * NINP; v = bf2f(p[C_CA + c]) * sigmoidf_(bf2f(p[C_CG + c])); }
        L[e] = v; }
    __syncthreads();
    { const int c = tid & 255, half = tid >> 8;
      float w[31];
#pragma unroll
      for (int k = 0; k < 31; ++k) w[k] = a.in[I_CVW][(size_t)(l * 31 + k) * WCV + c];
      const float bias = a.in[I_CVB][(size_t)l * WCV + c], gg = a.in[I_CVGG][(size_t)l * WCV + c], gb = a.in[I_CVGB][(size_t)l * WCV + c];
      for (int tt = 0; tt < 16; ++tt) { const int t = half * 16 + tt; float u = bias;
#pragma unroll
          for (int k = 0; k < 31; ++k) u += w[k] * L[(t + k) * 256 + c];
          const float mean = wave_sum(u) * (1.f / 64.f); const float dv = u - mean; const float var = wave_sum(dv * dv) * (1.f / 64.f);
          const float un = dv * (1.0f / sqrtf(var + EPS)) * gg + gb;
          CAT[(size_t)(tokbase + t0 + t) * D + 768 + c] = (bf16_t)f2bf(siluf_(un)); }
    }
    __syncthreads();
}
__device__ __forceinline__ void mixer2(KArgs& a) {
    const int g = blockIdx.x * NTHREADS + otid(), NT = gridDim.x * NTHREADS;
    { const float* AEND = (const float*)(a.ws + WS_AEND); const float* HEND = (const float*)(a.ws + WS_HEND); float* CIN = (float*)(a.ws + WS_CIN);
      for (int idx = g; idx < NB * WA; idx += NT) { const int b = idx / WA, c = idx % WA; float ae[32], he[32];
#pragma unroll
          for (int n = 0; n < 32; ++n) { ae[n] = AEND[(size_t)(b * 32 + n) * WA + c]; he[n] = HEND[(size_t)(b * 32 + n) * WA + c]; }
          float H = 0.f;
#pragma unroll
          for (int n = 0; n < 32; ++n) { CIN[(size_t)(b * 32 + n) * WA + c] = H; H = ae[n] * H + he[n]; } } }
    { float* U = (float*)(a.ws + WS_U); const float* DEC = (const float*)(a.ws + WS_DEC);
      for (int idx = g; idx < 32 * 4608; idx += NT) { const int bh = idx / 4608, de = idx % 4608, d = de / 96, b = bh >> 2, h = bh & 3; float uv[32], dc[32];
#pragma unroll
          for (int n = 0; n < 32; ++n) { uv[n] = U[(size_t)((b * 32 + n) * 4 + h) * 4608 + de]; dc[n] = DEC[(size_t)((b * 32 + n) * 4 + h) * 48 + d]; }
          float S = 0.f;
#pragma unroll
          for (int n = 0; n < 32; ++n) { U[(size_t)((b * 32 + n) * 4 + h) * 4608 + de] = S; S = dc[n] * S + uv[n]; } } }
}
__device__ __forceinline__ void rg_final(KArgs& a) {
    const int g = blockIdx.x * NTHREADS + otid(), NT = gridDim.x * NTHREADS;
    const float* HLOC = (const float*)(a.ws + WS_HLOC); const float* ACUM = (const float*)(a.ws + WS_ACUM); const float* CIN = (const float*)(a.ws + WS_CIN);
    const bf16_t* PROJ = (const bf16_t*)(a.ws + WS_R1); bf16_t* CAT = (bf16_t*)(a.ws + WS_CAT);
    for (int e = g; e < MTOK * WA; e += NT) { const int t = e / WA, c = e % WA;
        const float h = HLOC[e] + ACUM[e] * CIN[(size_t)(t >> 6) * WA + c];
        const float ya = bf2f(PROJ[(size_t)t * NINP + C_YA + c]);
        CAT[(size_t)t * D + c] = (bf16_t)f2bf(h * gelu_tanh(ya)); }
}
__device__ __forceinline__ void gla3(KArgs& a, int l, int item, LAS float* L) {
    const int tid = otid();
    const int h = item & 3, bn = item >> 2, b = bn >> 5, n = bn & 31, tok0 = b * SEQ + n * 64;
    const bf16_t* PROJ = (const bf16_t*)(a.ws + WS_R1); bf16_t* CAT = (bf16_t*)(a.ws + WS_CAT);
    LAS float* lr_s = L; LAS float* wg_s = L + 1024; LAS float* bg_s = L + 1792; LAS float* bc_s = L + 1856; LAS float* q_s = L + 4928; LAS float* k_s = L + 8256;
    LAS float* v_s = L + 11584; LAS float* sp_s = L + 17728; LAS float* sc_s = L + 22336;
    for (int e = tid; e < 3072; e += NTHREADS) { const int t = e / 48, d = e % 48; const bf16_t* p = PROJ + (size_t)(tok0 + t) * NINP + h * 48 + d;
        q_s[t * 52 + d] = bf2f(p[C_Q]); k_s[t * 52 + d] = bf2f(p[C_K]); }
    for (int e = tid; e < 6144; e += NTHREADS) { const int t = e / 96, c = e % 96; v_s[e] = bf2f(PROJ[(size_t)(tok0 + t) * NINP + C_V + h * 96 + c]); }
    { const float* U = (const float*)(a.ws + WS_U) + (size_t)(bn * 4 + h) * 4608; for (int e = tid; e < 4608; e += NTHREADS) sp_s[e] = U[e]; }
    gla_bcum(a, l, tok0, h, lr_s, wg_s, bg_s, bc_s);
    for (int e = tid; e < 3072; e += NTHREADS) { const int t = e / 48, d = e % 48; const float bc = bc_s[e];
        q_s[t * 52 + d] *= 0.14433756729740643f * __expf(bc); k_s[t * 52 + d] *= __expf(-bc); }
    __syncthreads();
    { const int ig = tid >> 4, jg = tid & 15; float acc[2][4];
#pragma unroll
      for (int x = 0; x < 2; ++x)
#pragma unroll
          for (int y = 0; y < 4; ++y) acc[x][y] = 0.f;
#pragma unroll 4
      for (int d4 = 0; d4 < 12; ++d4) {
          f32x4 qv[2], kv[4];
#pragma unroll
          for (int x = 0; x < 2; ++x) qv[x] = *(const LAS f32x4*)(q_s + (ig + 32 * x) * 52 + 4 * d4);
#pragma unroll
          for (int y = 0; y < 4; ++y) kv[y] = *(const LAS f32x4*)(k_s + (jg + 16 * y) * 52 + 4 * d4);
#pragma unroll
          for (int x = 0; x < 2; ++x)
#pragma unroll
              for (int y = 0; y < 4; ++y) acc[x][y] += (qv[x][0] * kv[y][0] + qv[x][1] * kv[y][1]) + (qv[x][2] * kv[y][2] + qv[x][3] * kv[y][3]);
      }
#pragma unroll
      for (int x = 0; x < 2; ++x)
#pragma unroll
          for (int y = 0; y < 4; ++y) { const int i = ig + 32 * x, j = jg + 16 * y; sc_s[i * 68 + j] = (j <= i) ? acc[x][y] : 0.f; }
    }
    __syncthreads();
    { const int ig = tid >> 5, eg = tid & 31; float acc[4][3];
#pragma unroll
      for (int x = 0; x < 4; ++x)
#pragma unroll
          for (int y = 0; y < 3; ++y) acc[x][y] = 0.f;
      for (int j4 = 0; j4 < 16; ++j4) {
          f32x4 s4[4];
#pragma unroll
          for (int x = 0; x < 4; ++x) s4[x] = *(const LAS f32x4*)(sc_s + (ig + 16 * x) * 68 + 4 * j4);
#pragma unroll
          for (int jj = 0; jj < 4; ++jj) { float vv[3];
#pragma unroll
              for (int y = 0; y < 3; ++y) vv[y] = v_s[(4 * j4 + jj) * 96 + eg + 32 * y];
#pragma unroll
              for (int x = 0; x < 4; ++x)
#pragma unroll
                  for (int y = 0; y < 3; ++y) acc[x][y] += s4[x][jj] * vv[y]; }
      }
      for (int d4 = 0; d4 < 12; ++d4) {
          f32x4 q4[4];
#pragma unroll
          for (int x = 0; x < 4; ++x) q4[x] = *(const LAS f32x4*)(q_s + (ig + 16 * x) * 52 + 4 * d4);
#pragma unroll
          for (int dd = 0; dd < 4; ++dd) { float sv[3];
#pragma unroll
              for (int y = 0; y < 3; ++y) sv[y] = sp_s[(4 * d4 + dd) * 96 + eg + 32 * y];
#pragma unroll
              for (int x = 0; x < 4; ++x)
#pragma unroll
                  for (int y = 0; y < 3; ++y) acc[x][y] += q4[x][dd] * sv[y]; }
      }
      const float* ng = a.in[I_GLANG] + (size_t)l * 96;
#pragma unroll
      for (int x = 0; x < 4; ++x) { const int i = ig + 16 * x;
          float ss = acc[x][0] * acc[x][0] + acc[x][1] * acc[x][1] + acc[x][2] * acc[x][2];
#pragma unroll
          for (int o = 1; o < 32; o <<= 1) ss += __shfl_xor(ss, o);
          const float r = 1.0f / sqrtf(ss * (1.f / 96.f) + EPS);
#pragma unroll
          for (int y = 0; y < 3; ++y) { const int e = eg + 32 * y;
              const float gate = bf2f(PROJ[(size_t)(tok0 + i) * NINP + C_G + h * 96 + e]);
              CAT[(size_t)(tok0 + i) * D + WA + h * 96 + e] = (bf16_t)f2bf(acc[x][y] * r * ng[e] * siluf_(gate)); } }
    }
    __syncthreads();
}

constexpr int PH_PER_LAYER = 17, N_PHASES = 1 + DEPTH * PH_PER_LAYER;

__device__ __forceinline__ void run_phase(KArgs& a, int p, LAS unsigned char* lds) {
    unsigned char* ws = a.ws;
    const int G = gridDim.x, bx = blockIdx.x;
    bf16_t* XN = (bf16_t*)(ws + WS_XN); float* Y = (float*)(ws + WS_Y); float* STATS = (float*)(ws + WS_STATS);
    if (p == 0) {
        convert_weights(a, 0, lds);
        cvt_rows(a.in[I_X], XN, (size_t)MTOK * D);
        cvt_rows(a.in[I_MEM], (bf16_t*)(ws + WS_MEMB), (size_t)MMEM * D);
        return;
    }
    const int l = (p - 1) / PH_PER_LAYER, s = (p - 1) % PH_PER_LAYER;
#ifdef TEST_ONLY
    if (s != TEST_ONLY) return;
#endif
    switch (s) {
    case 0: case 14: {
        StdProb S; S.init(XN, (const bf16_t*)(ws + (s == 0 ? WS_W1T_A : WS_W1T_B)), D, D, D, MTOK, 2 * FF, G, bx);
        EpiSwiGLU E{(bf16_t*)(ws + WS_R1)};
        gemm_phase(lds, S, E);
    } break;
    case 1: case 7: case 12: case 15: {
        const bf16_t* A; const bf16_t* Bt; int K; const float* g; const float* b; float scale; const float* Xin = nullptr;
        if (s == 1) { A = (const bf16_t*)(ws + WS_R1); Bt = (const bf16_t*)(ws + WS_W2T_A); K = FF; scale = 0.5f;
            if (l == 0) { Xin = a.in[I_X]; g = a.in[I_LN4G]; b = a.in[I_LN4B]; } else { g = a.in[I_LN4G] + (size_t)(l - 1) * D; b = a.in[I_LN4B] + (size_t)(l - 1) * D; } }
        else if (s == 7) { A = (const bf16_t*)(ws + WS_CAT); Bt = (const bf16_t*)(ws + WS_WOUTT); K = D; scale = 1.0f; g = a.in[I_LN1G] + (size_t)l * D; b = a.in[I_LN1B] + (size_t)l * D; }
        else if (s == 12) { A = (const bf16_t*)(ws + WS_CAT); Bt = (const bf16_t*)(ws + WS_WOT); K = D; scale = 1.0f; g = a.in[I_LN2G] + (size_t)l * D; b = a.in[I_LN2B] + (size_t)l * D; }
        else { A = (const bf16_t*)(ws + WS_R1); Bt = (const bf16_t*)(ws + WS_W2T_B); K = FF; scale = 0.5f; g = a.in[I_LN3G] + (size_t)l * D; b = a.in[I_LN3B] + (size_t)l * D; }
        StdProb S; S.init(A, Bt, K, K, K, MTOK, D, G, bx);
        EpiRes E{Y, Xin, STATS, g, b, scale};
        gemm_phase(lds, S, E);
    } break;
    case 2: case 8: case 13: case 16: {
        const float* gp = s == 2 ? a.in[I_LN1G] : s == 8 ? a.in[I_LN2G] : s == 13 ? a.in[I_LN3G] : a.in[I_LN4G];
        const float* bp = s == 2 ? a.in[I_LN1B] : s == 8 ? a.in[I_LN2B] : s == 13 ? a.in[I_LN3B] : a.in[I_LN4B];
        const bool fin = (s == 16 && l == DEPTH - 1);
        ln_phase(Y, gp + (size_t)l * D, bp + (size_t)l * D, XN, STATS, fin ? a.out : nullptr);
        if (s == 16 && l + 1 < DEPTH) convert_weights(a, l + 1, lds);
    } break;
    case 3: {
        { StdProb S; S.init(XN, (const bf16_t*)(ws + WS_WINT), D, D, D, MTOK, NINP, G, bx);
          EpiBf16 E{(bf16_t*)(ws + WS_R1), NINP, 1.0f}; gemm_phase(lds, S, E); }
        { StdProb S; S.init((const bf16_t*)(ws + WS_MEMB), (const bf16_t*)(ws + WS_WKVT), D, D, D, MMEM, D, G, (bx + G - (G / 2)) % G);
          EpiBf16 E{(bf16_t*)(ws + WS_KM), D, 1.0f}; gemm_phase(lds, S, E); }
        { StdProb S; S.init((const bf16_t*)(ws + WS_WKVT) + (size_t)D * D, (const bf16_t*)(ws + WS_MEMB), D, D, D, D, MMEM, G, (bx + G - (G / 2 + 32)) % G);
          EpiBf16 E{(bf16_t*)(ws + WS_VT), MMEM, 1.0f}; gemm_phase(lds, S, E); }
    } break;
    case 4: {
        LAS float* L = (LAS float*)lds;
        for (int it = bx; it < 3072; it += G) { if (it < 1536) rg_local(a, l, it, L); else if (it < 2560) gla1(a, l, it - 1536, L); else conv_item(a, l, it - 2560, L); }
    } break;
    case 5: mixer2(a); break;
    case 6: {
        LAS float* L = (LAS float*)lds;
        rg_final(a);
        for (int it = bx; it < 1024; it += G) gla3(a, l, it, L);
    } break;
    case 9: {
        StdProb S; S.init(XN, (const bf16_t*)(ws + WS_WQT), D, D, D, MTOK, D, G, bx);
        EpiBf16 E{(bf16_t*)(ws + WS_R1), D, 0.0625f}; gemm_phase(lds, S, E);
    } break;
    case 10: {
        ScoreProb S{(const bf16_t*)(ws + WS_R1), (const bf16_t*)(ws + WS_KM), D, D, 256, G, bx};
        EpiExp E{(bf16_t*)(ws + WS_R1 + R1_P_OFF), (float*)(ws + WS_PSUM)}; gemm_phase(lds, S, E);
    } break;
    case 11: {
        PVProb S{(const bf16_t*)(ws + WS_R1 + R1_P_OFF), (const bf16_t*)(ws + WS_VT), 256, MMEM, 256, G, bx};
        EpiPV E{(bf16_t*)(ws + WS_CAT), (const float*)(ws + WS_PSUM)}; gemm_phase(lds, S, E);
    } break;
    default: break;
    }
}

__global__ void __launch_bounds__(NTHREADS, 2) fwd_megakernel(Args args) {
    extern __shared__ __attribute__((aligned(16))) unsigned char lds_raw[];
    LAS unsigned char* lds = (LAS unsigned char*)lds_raw;
    cg::grid_group grid = cg::this_grid();
    volatile LAS unsigned* st = (volatile LAS unsigned*)(lds + 131072 + 4096);
    if (threadIdx.x < 2) st[threadIdx.x] = 0u;
    unsigned* barw = (unsigned*)(args.ws + WS_BAR);
    if (blockIdx.x == 0) for (int i = threadIdx.x; i < XCD_BAR_WORDS; i += NTHREADS) barw[i] = 0u;
    __syncthreads();
    XcdBarrier xb; xb.bar = barw; xb.x = 0; xb.st = st;
    const int ph_lo = args.ph_lo, ph_hi = args.ph_hi;
    for (int p = ph_lo; p < ph_hi; ++p) {
        KArgs* ap = (KArgs*)__builtin_amdgcn_kernarg_segment_ptr();
        asm volatile("" : "+s"(ap));
        run_phase(*ap, p, lds);
        if (p + 1 < ph_hi) {
            if (p == ph_lo) { grid.sync(); xb = xcd_barrier_post(barw, st); }
            else xcd_barrier(xb);
        }
    }
}

extern "C" void kernel_launch(void* const* d_in, const int* in_sizes, int n_in, void* d_out, int out_size, void* d_ws, size_t ws_size, hipStream_t stream) {
    static int grid = 0;
    if (grid == 0) {
        if (n_in != 33 || ws_size < WS_END) { fprintf(stderr, "kernel_launch: unexpected n_in %d or ws_size %zu (need %zu)\n", n_in, ws_size, (size_t)WS_END); grid = -1; return; }
        int dev = 0, cus = 0, per_cu = 0;
        (void)hipGetDevice(&dev);
        (void)hipDeviceGetAttribute(&cus, hipDeviceAttributeMultiprocessorCount, dev);
        if (hipFuncSetAttribute((const void*)fwd_megakernel, hipFuncAttributeMaxDynamicSharedMemorySize, LDS_BYTES) != hipSuccess) { fprintf(stderr, "kernel_launch: hipFuncSetAttribute failed\n"); grid = -1; return; }
        if (hipOccupancyMaxActiveBlocksPerMultiprocessor(&per_cu, (const void*)fwd_megakernel, NTHREADS, LDS_BYTES) != hipSuccess || per_cu < 1) { fprintf(stderr, "kernel_launch: occupancy query says %d\n", per_cu); per_cu = 1; }
        (void)hipGetLastError();
        grid = cus > 0 ? cus : 256;
    }
    if (grid < 0) return;
    Args a{};
    for (int i = 0; i < 33; ++i) a.in[i] = (const float*)d_in[i];
    a.out = (float*)d_out; a.ws = (unsigned char*)d_ws; a.ph_lo = 0; a.ph_hi = N_PHASES;
    void* kargs[] = {&a};
    hipError_t e = hipLaunchCooperativeKernel((const void*)fwd_megakernel, dim3(grid), dim3(NTHREADS), kargs, LDS_BYTES, stream);
    if (e != hipSuccess) fprintf(stderr, "cooperative launch failed: %s (grid %d)\n", hipGetErrorString(e), grid);
}
```

```cpp
#include <hip/hip_runtime.h>
#include <hip/hip_cooperative_groups.h>
#include <cstdio>
#include <cstdint>
namespace cg = cooperative_groups;

#define LAS __attribute__((address_space(3)))
typedef unsigned short bf16_t;
typedef short bf16x8 __attribute__((ext_vector_type(8)));
typedef float f32x4 __attribute__((ext_vector_type(4)));
typedef unsigned u32x4 __attribute__((ext_vector_type(4)));
typedef unsigned u32x2 __attribute__((ext_vector_type(2)));

constexpr int NB = 8, SEQ = 2048, MTOK = NB * SEQ, D = 1024, FF = 2816, NIN = 2448, NINP = 2560, DEPTH = 4, MEML = 256, MMEM = NB * MEML;
constexpr int WA = 384, WCV = 256;
constexpr float ALPHA = 1.6817928305074290f;
constexpr float EPS = 1e-5f;
constexpr int C_XA = 0, C_YA = 384, C_Q = 768, C_K = 960, C_V = 1152, C_G = 1536, C_LR = 1920, C_CA = 1936, C_CG = 2192;
constexpr int NTHREADS = 512;
constexpr int LDS_BYTES = 144 * 1024;

constexpr size_t al256(size_t x) { return (x + 255) & ~(size_t)255; }
constexpr size_t WS_W1T_A = 0;
constexpr size_t WS_W2T_A = WS_W1T_A + al256((size_t)2 * FF * D * 2);
constexpr size_t WS_W1T_B = WS_W2T_A + al256((size_t)D * FF * 2);
constexpr size_t WS_W2T_B = WS_W1T_B + al256((size_t)2 * FF * D * 2);
constexpr size_t WS_WINT = WS_W2T_B + al256((size_t)D * FF * 2);
constexpr size_t WS_WOUTT = WS_WINT + al256((size_t)NINP * D * 2);
constexpr size_t WS_WQT = WS_WOUTT + al256((size_t)D * D * 2);
constexpr size_t WS_WOT = WS_WQT + al256((size_t)D * D * 2);
constexpr size_t WS_WKVT = WS_WOT + al256((size_t)D * D * 2);
constexpr size_t WS_XN = WS_WKVT + al256((size_t)2 * D * D * 2);
constexpr size_t WS_Y = WS_XN + al256((size_t)MTOK * D * 2);
constexpr size_t WS_R1 = WS_Y + al256((size_t)MTOK * D * 4);
constexpr size_t WS_CAT = WS_R1 + al256((size_t)MTOK * FF * 2);
constexpr size_t WS_MEMB = WS_CAT + al256((size_t)MTOK * D * 2);
constexpr size_t WS_KM = WS_MEMB + al256((size_t)MMEM * D * 2);
constexpr size_t WS_VT = WS_KM + al256((size_t)MMEM * D * 2);
constexpr size_t WS_STATS = WS_VT + al256((size_t)MMEM * D * 2);
constexpr size_t WS_PSUM = WS_STATS + al256((size_t)MTOK * 2 * 4);
constexpr size_t WS_HLOC = WS_PSUM + al256((size_t)NB * 4 * SEQ * 4 * 4);
constexpr size_t WS_ACUM = WS_HLOC + al256((size_t)MTOK * WA * 4);
constexpr size_t WS_AEND = WS_ACUM + al256((size_t)MTOK * WA * 4);
constexpr size_t WS_HEND = WS_AEND + al256((size_t)NB * 32 * WA * 4);
constexpr size_t WS_CIN = WS_HEND + al256((size_t)NB * 32 * WA * 4);
constexpr size_t WS_U = WS_CIN + al256((size_t)NB * 32 * WA * 4);
constexpr size_t WS_DEC = WS_U + al256((size_t)NB * 32 * 4 * 4608 * 4);
constexpr size_t WS_BAR = WS_DEC + al256((size_t)NB * 32 * 4 * 48 * 4);
constexpr size_t WS_END = WS_BAR + al256((size_t)3456 * 4);
constexpr size_t R1_P_OFF = (size_t)MTOK * D * 2;

__device__ __forceinline__ float bf2f(bf16_t v) { return __uint_as_float(((unsigned)v) << 16); }
__device__ __forceinline__ unsigned f2bf(float f) { unsigned u = __float_as_uint(f); return (u + 0x7fffu + ((u >> 16) & 1u)) >> 16; }
__device__ __forceinline__ unsigned pk2(float lo, float hi) { return f2bf(lo) | (f2bf(hi) << 16); }
__device__ __forceinline__ float sigmoidf_(float x) { return 1.0f / (1.0f + __expf(-x)); }
__device__ __forceinline__ float siluf_(float x) { return x / (1.0f + __expf(-x)); }
__device__ __forceinline__ float gelu_tanh(float x) { const float u = 0.7978845608028654f * (x + 0.044715f * x * x * x); return 0.5f * x * (1.0f + tanhf(u)); }
__device__ __forceinline__ float wave_sum(float v) {
#pragma unroll
    for (int o = 1; o < 64; o <<= 1) v += __shfl_xor(v, o);
    return v;
}
#define LDS_WAIT() asm volatile("s_waitcnt lgkmcnt(0)" ::: "memory")
__device__ __forceinline__ int otid() { int t = threadIdx.x; asm volatile("" : "+v"(t)); return t; }


#define XB_TMO      128
#define XB_XCNT(j)  (256  + 64 * (j))
#define XB_XSUB(j)  (1280 + 64 * (j))
#define XB_XGEN(j)  (2304 + 64 * (j))
#define XB_TOP      3328
#define XB_TOPGEN   3392
#define XCD_BAR_WORDS 3456
#define XB_SPIN_CAP (1u << 18)
__device__ __forceinline__ unsigned xb_ld(unsigned* p)              { return __hip_atomic_load(p, __ATOMIC_RELAXED, __HIP_MEMORY_SCOPE_AGENT); }
__device__ __forceinline__ unsigned xb_add(unsigned* p, unsigned v) { return __hip_atomic_fetch_add(p, v, __ATOMIC_RELAXED, __HIP_MEMORY_SCOPE_AGENT); }
__device__ __forceinline__ unsigned xb_xcc_id() { return (unsigned)__builtin_amdgcn_s_getreg((3 << 11) | 20) & 0xFu; }
#define XB_SPIN(cond, bar) do { unsigned _sp = 0; while (cond) { __builtin_amdgcn_s_sleep(1); \
    if ((++_sp & 255u) == 0u) { if (xb_ld(&(bar)[XB_TMO])) break; if (_sp > XB_SPIN_CAP) { atomicAdd(&(bar)[XB_TMO], 1u); break; } } } } while (0)
struct XcdBarrier { unsigned* bar; unsigned x; volatile LAS unsigned* st; };
__device__ __forceinline__ XcdBarrier xcd_barrier_post(unsigned* bar, volatile LAS unsigned* st) {
    XcdBarrier b; b.bar = bar; b.x = xb_xcc_id(); b.st = st;
    if (threadIdx.x == 0) (void)xb_add(&bar[XB_XCNT(b.x)], 1u);
    return b;
}
__device__ __forceinline__ void xcd_barrier_complete(unsigned* bar, unsigned x, unsigned& nloc, unsigned& nx) {
    const unsigned G = gridDim.x * gridDim.y * gridDim.z;
    unsigned sum, cnt, mine, sp = 0u;
    for (;;) {
        sum = 0u; cnt = 0u; mine = 0u;
#pragma unroll
        for (unsigned j = 0; j < 16; ++j) { const unsigned c = xb_ld(&bar[XB_XCNT(j)]); sum += c; cnt += (c > 0u) ? 1u : 0u; mine = (j == x) ? c : mine; }
        if (sum == G) break;
        __builtin_amdgcn_s_sleep(1);
        if ((++sp & 255u) == 0u) { if (xb_ld(&bar[XB_TMO])) break; if (sp > XB_SPIN_CAP) { atomicAdd(&bar[XB_TMO], 1u); break; } }
    }
    nloc = mine > 0u ? mine : 1u; nx = cnt > 0u ? cnt : 1u;
}
__device__ __forceinline__ void xcd_barrier(const XcdBarrier& b) {
    asm volatile("s_waitcnt vmcnt(0)" ::: "memory");
    __syncthreads();
    if (threadIdx.x == 0) {
        unsigned* bar = b.bar;
        __builtin_amdgcn_s_waitcnt(0);
        unsigned nloc = b.st[0], nx = b.st[1];
        if (nloc == 0u) { xcd_barrier_complete(bar, b.x, nloc, nx); b.st[0] = nloc; b.st[1] = nx; }
        const unsigned old = xb_add(&bar[XB_XSUB(b.x)], 1u);
        const unsigned gen = old / nloc;
        if (old + 1u == (gen + 1u) * nloc) {
            __builtin_amdgcn_fence(__ATOMIC_RELEASE, "agent");
            asm volatile("s_waitcnt vmcnt(0)" ::: "memory");
            const unsigned og = xb_add(&bar[XB_TOP], 1u);
            const unsigned tg = og / nx;
            if (og + 1u == (tg + 1u) * nx) xb_add(&bar[XB_TOPGEN], 1u);
            else XB_SPIN(xb_ld(&bar[XB_TOPGEN]) == tg, bar);
            __builtin_amdgcn_fence(__ATOMIC_ACQUIRE, "agent");
            xb_add(&bar[XB_XGEN(b.x)], 1u);
            asm volatile("s_waitcnt vmcnt(0)" ::: "memory");
        } else {
            XB_SPIN(xb_ld(&bar[XB_XGEN(b.x)]) == gen, bar);
            __builtin_amdgcn_fence(__ATOMIC_ACQUIRE, "agent");
            asm volatile("s_waitcnt vmcnt(0)" ::: "memory");
        }
    }
    __syncthreads();
}

constexpr int BM = 256, BK = 64, HALF = 128, HTB = HALF * BK * 2, NXCD = 8, WGM = 8;
__device__ __forceinline__ int lds_byte(int r, int c) { const int st = (r >> 4) * 2 + (c >> 5), rr = r & 15, cc = c & 31, ob = rr * 64 + cc * 2; return st * 1024 + (ob ^ (((ob >> 9) & 1) << 5)); }
__device__ __forceinline__ void stage_rc(int b, int& R, int& C) { const int st = b / 1024, sb = b % 1024, swz = sb ^ (((sb >> 9) & 1) << 5); R = (st >> 1) * 16 + swz / 64; C = (st & 1) * 32 + (swz % 64) / 2; }
__device__ __forceinline__ int perm32(int rho) { const int n = rho >> 4, i = rho & 15; return 8 * (i >> 2) + 4 * n + (i & 3); }

struct Unit { int pm, pn; };

struct StdProb {
    const bf16_t* A; const bf16_t* Bt; int lda, ldb, K;
    int nM, nN, nwg, G, c;
    __device__ __forceinline__ void init(const bf16_t* A_, const bf16_t* Bt_, int lda_, int ldb_, int K_, int M_, int N_, int G_, int c_) {
        A = A_; Bt = Bt_; lda = lda_; ldb = ldb_; K = K_; nM = M_ / BM; nN = N_ / BM; nwg = nM * nN; G = G_; c = c_; }
    __device__ __forceinline__ bool next(int i, Unit& u) const {
        const long L = (long)i * G + c; if (L >= nwg) return false;
        int wgid = (int)L; { const int q = nwg / NXCD, r = nwg % NXCD, xcd = wgid % NXCD, off = wgid / NXCD; wgid = (xcd < r ? xcd * (q + 1) : r * (q + 1) + (xcd - r) * q) + off; }
        const int nig = WGM * nN, gid = wgid / nig, fm = gid * WGM, gsz = (nM - fm) < WGM ? (nM - fm) : WGM;
        u.pm = fm + ((wgid % nig) % gsz); u.pn = (wgid % nig) / gsz; return true;
    }
    __device__ __forceinline__ const char* aptr(const Unit& u) const { return (const char*)(A + (size_t)u.pm * BM * lda); }
    __device__ __forceinline__ const char* bptr(const Unit& u) const { return (const char*)(Bt + (size_t)u.pn * BM * ldb); }
};
struct ScoreProb {
    const bf16_t* Q; const bf16_t* Km; int lda, ldb, K; int G, c;
    __device__ __forceinline__ bool next(int i, Unit& u) const { const long L = (long)i * G + c; if (L >= 256) return false; u.pm = (int)L; u.pn = 0; return true; }
    __device__ __forceinline__ const char* aptr(const Unit& u) const { const int b = u.pm >> 5, h = (u.pm >> 3) & 3, mt = u.pm & 7; return (const char*)(Q + ((size_t)(b * SEQ + mt * 256) * D + h * 256)); }
    __device__ __forceinline__ const char* bptr(const Unit& u) const { const int b = u.pm >> 5, h = (u.pm >> 3) & 3; return (const char*)(Km + ((size_t)(b * MEML) * D + h * 256)); }
};
struct PVProb {
    const bf16_t* P; const bf16_t* VT; int lda, ldb, K; int G, c;
    __device__ __forceinline__ bool next(int i, Unit& u) const { const long L = (long)i * G + c; if (L >= 256) return false; u.pm = (int)L; u.pn = 0; return true; }
    __device__ __forceinline__ const char* aptr(const Unit& u) const { return (const char*)(P + (size_t)u.pm * 256 * 256); }
    __device__ __forceinline__ const char* bptr(const Unit& u) const { const int b = u.pm >> 5, h = (u.pm >> 3) & 3; return (const char*)(VT + ((size_t)(h * 256) * MMEM + b * MEML)); }
};

struct EpiSwiGLU {
    static constexpr bool PERM = true;
    bf16_t* H;
    __device__ __forceinline__ void operator()(const f32x4 (&acc)[2][2][4][2], const Unit& u, int wr, int wc, int fr, int fq) const {
        const int row0 = u.pm * BM + wr * 64 + fr, col0 = u.pn * 128 + wc * 32 + 8 * fq;
#pragma unroll
        for (int ai = 0; ai < 2; ++ai)
#pragma unroll
            for (int m = 0; m < 4; ++m) {
                bf16_t* rowp = H + (size_t)(row0 + ai * HALF + m * 16) * FF + col0;
                const f32x4 g0 = acc[ai][0][m][0], g1 = acc[ai][0][m][1], u0 = acc[ai][1][m][0], u1 = acc[ai][1][m][1];
                u32x4 w;
                w.x = pk2(siluf_(g0[0]) * u0[0], siluf_(g0[1]) * u0[1]); w.y = pk2(siluf_(g0[2]) * u0[2], siluf_(g0[3]) * u0[3]);
                w.z = pk2(siluf_(g1[0]) * u1[0], siluf_(g1[1]) * u1[1]); w.w = pk2(siluf_(g1[2]) * u1[2], siluf_(g1[3]) * u1[3]);
                *(u32x4*)rowp = w;
            }
    }
};
struct EpiBf16 {
    static constexpr bool PERM = true;
    bf16_t* O; int ldc; float scale;
    __device__ __forceinline__ void operator()(const f32x4 (&acc)[2][2][4][2], const Unit& u, int wr, int wc, int fr, int fq) const {
        const int row0 = u.pm * BM + wr * 64 + fr, col0 = u.pn * BM + wc * 32 + 8 * fq;
#pragma unroll
        for (int ai = 0; ai < 2; ++ai)
#pragma unroll
            for (int m = 0; m < 4; ++m) {
                bf16_t* rowp = O + (size_t)(row0 + ai * HALF + m * 16) * ldc + col0;
#pragma unroll
                for (int bj = 0; bj < 2; ++bj) {
                    const f32x4 v0 = acc[ai][bj][m][0] * scale, v1 = acc[ai][bj][m][1] * scale;
                    u32x4 w; w.x = pk2(v0[0], v0[1]); w.y = pk2(v0[2], v0[3]); w.z = pk2(v1[0], v1[1]); w.w = pk2(v1[2], v1[3]);
                    *(u32x4*)(rowp + bj * HALF) = w;
                }
            }
    }
};
struct EpiRes {
    static constexpr bool PERM = false;
    float* Y; const float* Xin; const float* stats; const float* g; const float* b; float scale;
    __device__ __forceinline__ void operator()(const f32x4 (&acc)[2][2][4][2], const Unit& u, int wr, int wc, int fr, int fq) const {
        const int row0 = u.pm * BM + wr * 64 + fr, col0 = u.pn * BM + wc * 32 + 4 * fq;
        f32x4 gv[2][2], bv[2][2];
#pragma unroll
        for (int bj = 0; bj < 2; ++bj)
#pragma unroll
            for (int n = 0; n < 2; ++n) { gv[bj][n] = *(const f32x4*)(g + col0 + bj * HALF + n * 16); bv[bj][n] = *(const f32x4*)(b + col0 + bj * HALF + n * 16); }
#pragma unroll
        for (int ai = 0; ai < 2; ++ai)
#pragma unroll
            for (int m = 0; m < 4; ++m) {
                const int row = row0 + ai * HALF + m * 16;
                const float mean = stats[2 * row], rstd = stats[2 * row + 1];
                float* rowp = Y + (size_t)row * D + col0;
                const float* xrow = Xin ? (Xin + (size_t)row * D + col0) : rowp;
#pragma unroll
                for (int bj = 0; bj < 2; ++bj)
#pragma unroll
                    for (int n = 0; n < 2; ++n) {
                        f32x4 xv = *(const f32x4*)(xrow + bj * HALF + n * 16);
                        if (!Xin) xv = (xv - mean) * rstd * gv[bj][n] + bv[bj][n];
                        *(f32x4*)(rowp + bj * HALF + n * 16) = xv * ALPHA + acc[ai][bj][m][n] * scale;
                    }
            }
    }
};
struct EpiExp {
    static constexpr bool PERM = true;
    bf16_t* P; float* psum;
    __device__ __forceinline__ void operator()(const f32x4 (&acc)[2][2][4][2], const Unit& u, int wr, int wc, int fr, int fq) const {
        const int row0 = u.pm * BM + wr * 64 + fr, col0 = wc * 32 + 8 * fq;
#pragma unroll
        for (int ai = 0; ai < 2; ++ai)
#pragma unroll
            for (int m = 0; m < 4; ++m) {
                const int row = row0 + ai * HALF + m * 16;
                bf16_t* rowp = P + (size_t)row * 256 + col0;
                float s = 0.f;
#pragma unroll
                for (int bj = 0; bj < 2; ++bj) {
                    unsigned e[8];
#pragma unroll
                    for (int j = 0; j < 4; ++j) { e[j] = f2bf(__expf(fminf(acc[ai][bj][m][0][j], 80.f))); e[4 + j] = f2bf(__expf(fminf(acc[ai][bj][m][1][j], 80.f))); }
#pragma unroll
                    for (int j = 0; j < 8; ++j) s += __uint_as_float(e[j] << 16);
                    u32x4 w; w.x = e[0] | (e[1] << 16); w.y = e[2] | (e[3] << 16); w.z = e[4] | (e[5] << 16); w.w = e[6] | (e[7] << 16);
                    *(u32x4*)(rowp + bj * HALF) = w;
                }
                s += __shfl_xor(s, 16); s += __shfl_xor(s, 32);
                if (fq == 0) psum[(size_t)row * 4 + wc] = s;
            }
    }
};
struct EpiPV {
    static constexpr bool PERM = true;
    bf16_t* O; const float* psum;
    __device__ __forceinline__ void operator()(const f32x4 (&acc)[2][2][4][2], const Unit& u, int wr, int wc, int fr, int fq) const {
        const int b = u.pm >> 5, h = (u.pm >> 3) & 3, mt = u.pm & 7;
        const int rl0 = wr * 64 + fr, col0 = h * 256 + wc * 32 + 8 * fq;
#pragma unroll
        for (int ai = 0; ai < 2; ++ai)
#pragma unroll
            for (int m = 0; m < 4; ++m) {
                int rl = rl0 + ai * HALF + m * 16; asm volatile("" : "+v"(rl));
                const f32x4 ps = *(const f32x4*)(psum + ((size_t)u.pm * 256 + rl) * 4);
                const float inv = 1.0f / ((ps[0] + ps[1]) + (ps[2] + ps[3]));
                bf16_t* rowp = O + (size_t)(b * SEQ + mt * 256 + rl) * D + col0;
#pragma unroll
                for (int bj = 0; bj < 2; ++bj) {
                    const f32x4 v0 = acc[ai][bj][m][0] * inv, v1 = acc[ai][bj][m][1] * inv;
                    u32x4 w; w.x = pk2(v0[0], v0[1]); w.y = pk2(v0[2], v0[3]); w.z = pk2(v1[0], v1[1]); w.w = pk2(v1[2], v1[3]);
                    *(u32x4*)(rowp + bj * HALF) = w;
                }
                __builtin_amdgcn_sched_barrier(0);
            }
    }
};

template <class Prob, class Epi>
__device__ __forceinline__ void gemm_phase(LAS unsigned char* lds, const Prob& S, const Epi& E) {
    const int tid = otid(), wid = __builtin_amdgcn_readfirstlane(tid >> 6), lane = tid & 63, wr = wid >> 2, wc = wid & 3, fr = lane & 15, fq = lane >> 4;
    const int K = S.K, nt = K / BK, lda = S.lda, ldb = S.ldb;
    unsigned voffA[2], voffB[2];
#pragma unroll
    for (int i = 0; i < 2; ++i) { int R, C; stage_rc(tid * 16 + i * 8192, R, C); const int Rb = Epi::PERM ? ((R & ~31) + perm32(R & 31)) : R;
        voffA[i] = (unsigned)(R * lda + C) * 2u; voffB[i] = (unsigned)(Rb * ldb + C) * 2u; }
    const size_t kstep = (size_t)(BK * 2);
    const size_t hA = (size_t)HALF * lda * 2, hB = (size_t)HALF * ldb * 2;
    const unsigned ldsw = (unsigned)wid * 1024u;
    const int aoff = lds_byte(wr * 64 + fr, fq * 8), boff = lds_byte(wc * 32 + fr, fq * 8);
#define PG8_SA(b, h) (((b) * 2 + (h)) * HTB)
#define PG8_SB(b, h) ((4 + (b) * 2 + (h)) * HTB)
#define PG8_STAGE(bufoff, gbase, voff) do { _Pragma("unroll") for (int _i = 0; _i < 2; ++_i) \
        __builtin_amdgcn_global_load_lds((const unsigned*)((const char*)(gbase) + (voff)[_i]), (LAS unsigned*)(lds + (bufoff) + ldsw + _i * 8192), 16, 0, 0); } while (0)
#define PG8_LDA(dst, b, h) do { _Pragma("unroll") for (int m = 0; m < 4; ++m) _Pragma("unroll") for (int k = 0; k < 2; ++k) dst[m][k] = *(const LAS bf16x8*)(lds + PG8_SA(b, h) + aoff + m * 2048 + k * 1024); } while (0)
#define PG8_LDB(dst, b, h) do { _Pragma("unroll") for (int n = 0; n < 2; ++n) _Pragma("unroll") for (int k = 0; k < 2; ++k) dst[n][k] = *(const LAS bf16x8*)(lds + PG8_SB(b, h) + boff + n * 2048 + k * 1024); } while (0)
#define PG8_MMA(ai, bj, At, Bt) do { __builtin_amdgcn_s_setprio(1); _Pragma("unroll") for (int m = 0; m < 4; ++m) _Pragma("unroll") for (int n = 0; n < 2; ++n) _Pragma("unroll") for (int k = 0; k < 2; ++k) \
        acc[ai][bj][m][n] = __builtin_amdgcn_mfma_f32_16x16x32_bf16(Bt[n][k], At[m][k], acc[ai][bj][m][n], 0, 0, 0); __builtin_amdgcn_s_setprio(0); } while (0)
#define PG8_WAIT_V(n) asm volatile("s_waitcnt vmcnt(" #n ")" ::: "memory")
#define PG8_WAIT_L(n) asm volatile("s_waitcnt lgkmcnt(" #n ")" ::: "memory")
#define PG8_BAR __builtin_amdgcn_s_barrier()
#define PG8_SCHED __builtin_amdgcn_sched_barrier(0)
    Unit cur, nxt; int ui = 0;
    if (!S.next(0, cur)) return;
    f32x4 acc[2][2][4][2];
#pragma unroll
    for (int a = 0; a < 2; ++a)
#pragma unroll
        for (int b = 0; b < 2; ++b)
#pragma unroll
            for (int m = 0; m < 4; ++m)
#pragma unroll
                for (int n = 0; n < 2; ++n) acc[a][b][m][n] = (f32x4){0.f, 0.f, 0.f, 0.f};
    bf16x8 At[4][2], B0[2][2], B1[2][2];
    const char* cA = S.aptr(cur); const char* cB = S.bptr(cur);
    PG8_STAGE(PG8_SB(0, 0), cB, voffB); PG8_STAGE(PG8_SA(0, 0), cA, voffA); PG8_STAGE(PG8_SB(0, 1), cB + hB, voffB); PG8_STAGE(PG8_SA(0, 1), cA + hA, voffA);
    if (wr == 1) PG8_BAR;
    PG8_WAIT_V(4); PG8_BAR;
    PG8_STAGE(PG8_SB(1, 0), cB + kstep, voffB); PG8_STAGE(PG8_SA(1, 0), cA + kstep, voffA); PG8_STAGE(PG8_SB(1, 1), cB + hB + kstep, voffB);
    PG8_WAIT_V(6); PG8_BAR;
    for (;;) {
        const bool has_next = S.next(ui + 1, nxt);
        const char* nA = has_next ? S.aptr(nxt) : cA; const char* nB = has_next ? S.bptr(nxt) : cB;
        for (int t = 0; t < nt; t += 2) {
            const bool last = (t == nt - 2);
            const char* a1 = cA + (size_t)(t + 1) * kstep;
            const char* a2 = last ? nA : cA + (size_t)(t + 2) * kstep; const char* b2 = last ? nB : cB + (size_t)(t + 2) * kstep;
            const char* a3 = a2 + kstep; const char* b3 = b2 + kstep;
            PG8_LDB(B0, 0, 0); PG8_SCHED; PG8_LDA(At, 0, 0); PG8_STAGE(PG8_SA(1, 1), a1 + hA, voffA);
            PG8_WAIT_L(8); PG8_BAR; PG8_WAIT_L(0); PG8_MMA(0, 0, At, B0); PG8_BAR; PG8_SCHED;
            PG8_LDB(B1, 0, 1); PG8_STAGE(PG8_SB(0, 0), b2, voffB);
            PG8_BAR; PG8_WAIT_L(0); PG8_MMA(0, 1, At, B1); PG8_BAR;
            PG8_LDA(At, 0, 1); PG8_STAGE(PG8_SA(0, 0), a2, voffA);
            PG8_BAR; PG8_WAIT_L(0); PG8_MMA(1, 0, At, B0); PG8_BAR; PG8_SCHED;
            PG8_STAGE(PG8_SB(0, 1), b2 + hB, voffB);
            PG8_WAIT_V(6); PG8_BAR; PG8_MMA(1, 1, At, B1); PG8_BAR;
            PG8_LDB(B0, 1, 0); PG8_SCHED; PG8_LDA(At, 1, 0); PG8_STAGE(PG8_SA(0, 1), a2 + hA, voffA);
            PG8_WAIT_L(8); PG8_BAR; PG8_WAIT_L(0); PG8_MMA(0, 0, At, B0); PG8_BAR; PG8_SCHED;
            PG8_LDB(B1, 1, 1); PG8_STAGE(PG8_SB(1, 0), b3, voffB);
            PG8_BAR; PG8_WAIT_L(0); PG8_MMA(0, 1, At, B1); PG8_BAR;
            PG8_LDA(At, 1, 1); PG8_STAGE(PG8_SA(1, 0), a3, voffA);
            PG8_BAR; PG8_WAIT_L(0); PG8_MMA(1, 0, At, B0); PG8_BAR; PG8_SCHED;
            PG8_STAGE(PG8_SB(1, 1), b3 + hB, voffB);
            PG8_WAIT_V(6); PG8_BAR; PG8_MMA(1, 1, At, B1); PG8_BAR;
        }
        E(acc, cur, wr, wc, fr, fq);
        if (!has_next) break;
#pragma unroll
        for (int a = 0; a < 2; ++a)
#pragma unroll
            for (int b = 0; b < 2; ++b)
#pragma unroll
                for (int m = 0; m < 4; ++m)
#pragma unroll
                    for (int n = 0; n < 2; ++n) acc[a][b][m][n] = (f32x4){0.f, 0.f, 0.f, 0.f};
        cur = nxt; cA = nA; cB = nB; ++ui;
    }
    PG8_WAIT_V(0);
    if (wr == 0) PG8_BAR;
    PG8_BAR;
#undef PG8_SA
#undef PG8_SB
#undef PG8_STAGE
#undef PG8_LDA
#undef PG8_LDB
#undef PG8_MMA
#undef PG8_WAIT_V
#undef PG8_WAIT_L
#undef PG8_BAR
#undef PG8_SCHED
}

struct Args { const float* in[33]; float* out; unsigned char* ws; int ph_lo, ph_hi; };
typedef const Args __attribute__((address_space(4))) KArgs;
enum { I_X = 0, I_MEM, I_F1IN, I_F1OUT, I_LN1G, I_LN1B, I_MIXIN, I_RGCW, I_RGCB, I_RGWR, I_RGBR, I_RGWI, I_RGBI, I_RGLAM, I_GLAWG, I_GLABG, I_GLANG,
       I_CVW, I_CVB, I_CVGG, I_CVGB, I_MIXOUT, I_LN2G, I_LN2B, I_XAQ, I_XAKV, I_XAO, I_LN3G, I_LN3B, I_F2IN, I_F2OUT, I_LN4G, I_LN4B };

__device__ __forceinline__ void transpose_item(const float* W, int K, int Nsrc, int k0, int n0, bf16_t* WT, int drow0, LAS float* scr, int lane) {
    const int col = n0 + (lane & 31); const bool ok = col < Nsrc;
#pragma unroll 8
    for (int i = 0; i < 32; ++i) { const int kk = 2 * i + (lane >> 5); scr[kk * 33 + (lane & 31)] = ok ? W[(size_t)(k0 + kk) * Nsrc + col] : 0.f; }
    LDS_WAIT();
    const int c = lane & 7;
#pragma unroll
    for (int j = 0; j < 4; ++j) { const int n = (lane >> 3) + 8 * j; const LAS float* s = scr + (8 * c) * 33 + n;
        u32x4 o; o.x = pk2(s[0 * 33], s[1 * 33]); o.y = pk2(s[2 * 33], s[3 * 33]); o.z = pk2(s[4 * 33], s[5 * 33]); o.w = pk2(s[6 * 33], s[7 * 33]);
        *(u32x4*)(WT + (size_t)(drow0 + n) * K + k0 + 8 * c) = o; }
    LDS_WAIT();
}
__device__ __forceinline__ int w1_row(int n0) { const int up = n0 >= FF ? 1 : 0, j = n0 - up * FF; return 256 * (j >> 7) + 128 * up + (j & 127); }

__device__ __forceinline__ void convert_weights(KArgs& a, int l, LAS unsigned char* lds) {
    const int tid_ = otid(); const int lane = tid_ & 63, wave = tid_ >> 6;
    LAS float* scr = (LAS float*)(lds + wave * 16384);
    const int gw = blockIdx.x * 8 + wave, NGW = gridDim.x * 8;
    unsigned char* ws = a.ws;
    constexpr int I_1 = (D / 64) * (2 * FF / 32), I_2 = (FF / 64) * (D / 32), I_IN = (D / 64) * (NINP / 32), I_SQ = (D / 64) * (D / 32), I_KV = (D / 64) * (2 * D / 32);
    constexpr int NITEMS = 2 * I_1 + 2 * I_2 + I_IN + 3 * I_SQ + I_KV;
    for (int it = gw; it < NITEMS; it += NGW) {
        int r = it;
        if (r < I_1) { const int nb = 2 * FF / 32, kb = r / nb, n0 = (r % nb) * 32; transpose_item(a.in[I_F1IN] + (size_t)l * D * 2 * FF, D, 2 * FF, kb * 64, n0, (bf16_t*)(ws + WS_W1T_A), w1_row(n0), scr, lane); continue; } r -= I_1;
        if (r < I_1) { const int nb = 2 * FF / 32, kb = r / nb, n0 = (r % nb) * 32; transpose_item(a.in[I_F2IN] + (size_t)l * D * 2 * FF, D, 2 * FF, kb * 64, n0, (bf16_t*)(ws + WS_W1T_B), w1_row(n0), scr, lane); continue; } r -= I_1;
        if (r < I_2) { const int nb = D / 32, kb = r / nb, n0 = (r % nb) * 32; transpose_item(a.in[I_F1OUT] + (size_t)l * FF * D, FF, D, kb * 64, n0, (bf16_t*)(ws + WS_W2T_A), n0, scr, lane); continue; } r -= I_2;
        if (r < I_2) { const int nb = D / 32, kb = r / nb, n0 = (r % nb) * 32; transpose_item(a.in[I_F2OUT] + (size_t)l * FF * D, FF, D, kb * 64, n0, (bf16_t*)(ws + WS_W2T_B), n0, scr, lane); continue; } r -= I_2;
        if (r < I_IN) { const int nb = NINP / 32, kb = r / nb, n0 = (r % nb) * 32; transpose_item(a.in[I_MIXIN] + (size_t)l * D * NIN, D, NIN, kb * 64, n0, (bf16_t*)(ws + WS_WINT), n0, scr, lane); continue; } r -= I_IN;
        if (r < I_SQ) { const int nb = D / 32, kb = r / nb, n0 = (r % nb) * 32; transpose_item(a.in[I_MIXOUT] + (size_t)l * D * D, D, D, kb * 64, n0, (bf16_t*)(ws + WS_WOUTT), n0, scr, lane); continue; } r -= I_SQ;
        if (r < I_SQ) { const int nb = D / 32, kb = r / nb, n0 = (r % nb) * 32; transpose_item(a.in[I_XAQ] + (size_t)l * D * D, D, D, kb * 64, n0, (bf16_t*)(ws + WS_WQT), n0, scr, lane); continue; } r -= I_SQ;
        if (r < I_SQ) { const int nb = D / 32, kb = r / nb, n0 = (r % nb) * 32; transpose_item(a.in[I_XAO] + (size_t)l * D * D, D, D, kb * 64, n0, (bf16_t*)(ws + WS_WOT), n0, scr, lane); continue; } r -= I_SQ;
        { const int nb = 2 * D / 32, kb = r / nb, n0 = (r % nb) * 32; transpose_item(a.in[I_XAKV] + (size_t)l * D * 2 * D, D, 2 * D, kb * 64, n0, (bf16_t*)(ws + WS_WKVT), n0, scr, lane); }
    }
}
__device__ __forceinline__ void cvt_rows(const float* src, bf16_t* dst, size_t n) {
    const size_t g = (size_t)blockIdx.x * NTHREADS + otid(), NT = (size_t)gridDim.x * NTHREADS;
    for (size_t i = g; i < n / 4; i += NT) { const f32x4 v = ((const f32x4*)src)[i]; u32x2 o; o.x = pk2(v[0], v[1]); o.y = pk2(v[2], v[3]); ((u32x2*)dst)[i] = o; }
}
__device__ __forceinline__ void ln_phase(const float* Y, const float* g, const float* b, bf16_t* XN, float* stats, float* out) {
    const int tid_ = otid(); const int lane = tid_ & 63, wave = tid_ >> 6;
    const int gw = blockIdx.x * 8 + wave, NGW = gridDim.x * 8;
    f32x4 gv[4], bv[4];
#pragma unroll
    for (int j = 0; j < 4; ++j) { gv[j] = ((const f32x4*)g)[64 * j + lane]; bv[j] = ((const f32x4*)b)[64 * j + lane]; }
    f32x4 v[4];
    if (gw < MTOK) { const f32x4* xr = (const f32x4*)(Y + (size_t)gw * D) + lane;
#pragma unroll
        for (int j = 0; j < 4; ++j) v[j] = xr[64 * j]; }
    for (int row = gw; row < MTOK; row += NGW) {
        f32x4 nv[4]; const int nrow = row + NGW;
        if (nrow < MTOK) { const f32x4* xr = (const f32x4*)(Y + (size_t)nrow * D) + lane;
#pragma unroll
            for (int j = 0; j < 4; ++j) nv[j] = xr[64 * j]; }
        float s = 0.f;
#pragma unroll
        for (int j = 0; j < 4; ++j) s += (v[j][0] + v[j][1]) + (v[j][2] + v[j][3]);
        const float mean = wave_sum(s) * (1.f / D); float s2 = 0.f;
#pragma unroll
        for (int j = 0; j < 4; ++j) { const f32x4 d = v[j] - mean; s2 += (d[0] * d[0] + d[1] * d[1]) + (d[2] * d[2] + d[3] * d[3]); }
        const float rstd = 1.0f / sqrtf(wave_sum(s2) * (1.f / D) + EPS);
        if (lane == 0) { stats[2 * row] = mean; stats[2 * row + 1] = rstd; }
        u32x2* o8 = (u32x2*)(XN + (size_t)row * D) + lane;
#pragma unroll
        for (int j = 0; j < 4; ++j) {
            const f32x4 o = (v[j] - mean) * rstd * gv[j] + bv[j];
            u32x2 w; w.x = pk2(o[0], o[1]); w.y = pk2(o[2], o[3]); o8[64 * j] = w;
            if (out) ((f32x4*)(out + (size_t)row * D))[64 * j + lane] = o;
        }
#pragma unroll
        for (int j = 0; j < 4; ++j) v[j] = nv[j];
    }
}

__device__ __forceinline__ void unpack8(const u32x4 w, f32x4& lo, f32x4& hi) {
    lo[0] = __uint_as_float(w.x << 16); lo[1] = __uint_as_float(w.x & 0xffff0000u); lo[2] = __uint_as_float(w.y << 16); lo[3] = __uint_as_float(w.y & 0xffff0000u);
    hi[0] = __uint_as_float(w.z << 16); hi[1] = __uint_as_float(w.z & 0xffff0000u); hi[2] = __uint_as_float(w.w << 16); hi[3] = __uint_as_float(w.w & 0xffff0000u);
}
__device__ __forceinline__ void st8(LAS float* p, const u32x4 w) { f32x4 lo, hi; unpack8(w, lo, hi); *(LAS f32x4*)p = lo; *(LAS f32x4*)(p + 4) = hi; }

__device__ __forceinline__ void rg_local(KArgs& a, int l, int item, LAS float* L) {
    const int tid = otid();
    const int hd = item % 6, bn = item / 6, b = bn >> 5, n = bn & 31, t0 = n * 64, tokbase = b * SEQ;
    const bf16_t* PROJ = (const bf16_t*)(a.ws + WS_R1);
    LAS float* xa_s = L; LAS float* xc_s = L + 4288; LAS float* wr_s = L + 8448; LAS float* wi_s = L + 12544; LAS float* a_s = L + 16640; LAS float* u_s = L + 20736;
    LAS float* sg_s = L + 24832;
    const int c = tid & 63;
    {
        const u32x4 z = {0u, 0u, 0u, 0u}; u32x4 xv0 = z, xv1 = z;
        { const int r = tid >> 3, s = t0 - 3 + r; if (s >= 0) xv0 = *(const u32x4*)(PROJ + (size_t)(tokbase + s) * NINP + C_XA + hd * 64 + (tid & 7) * 8); }
        if (tid < 24) { const int r = 64 + (tid >> 3), s = t0 - 3 + r; xv1 = *(const u32x4*)(PROJ + (size_t)(tokbase + s) * NINP + C_XA + hd * 64 + (tid & 7) * 8); }
        const f32x4* wr4 = (const f32x4*)(a.in[I_RGWR] + (size_t)(l * 6 + hd) * 4096); const f32x4* wi4 = (const f32x4*)(a.in[I_RGWI] + (size_t)(l * 6 + hd) * 4096);
        const f32x4 w0 = wr4[tid], w1 = wr4[tid + 512], w2 = wi4[tid], w3 = wi4[tid + 512];
        st8(xa_s + tid * 8, xv0); if (tid < 24) st8(xa_s + (512 + tid) * 8, xv1);
        *(LAS f32x4*)(wr_s + tid * 4) = w0; *(LAS f32x4*)(wr_s + (tid + 512) * 4) = w1; *(LAS f32x4*)(wi_s + tid * 4) = w2; *(LAS f32x4*)(wi_s + (tid + 512) * 4) = w3;
    }
    const int ch = hd * 64 + c;
    float cw[4];
#pragma unroll
    for (int k = 0; k < 4; ++k) cw[k] = a.in[I_RGCW][(size_t)(l * 4 + k) * WA + ch];
    const float cbv = a.in[I_RGCB][(size_t)l * WA + ch];
    const int jg = tid & 7;
    const f32x4 br0 = *(const f32x4*)(a.in[I_RGBR] + (size_t)l * WA + hd * 64 + jg * 8), br1 = *(const f32x4*)(a.in[I_RGBR] + (size_t)l * WA + hd * 64 + jg * 8 + 4);
    const f32x4 bi0 = *(const f32x4*)(a.in[I_RGBI] + (size_t)l * WA + hd * 64 + jg * 8), bi1 = *(const f32x4*)(a.in[I_RGBI] + (size_t)l * WA + hd * 64 + jg * 8 + 4);
    const f32x4 lm0 = *(const f32x4*)(a.in[I_RGLAM] + (size_t)l * WA + hd * 64 + jg * 8), lm1 = *(const f32x4*)(a.in[I_RGLAM] + (size_t)l * WA + hd * 64 + jg * 8 + 4);
    __syncthreads();
#pragma unroll
    for (int i = 0; i < 8; ++i) { const int t = (tid >> 6) + 8 * i; float acc = cbv;
#pragma unroll
        for (int k = 0; k < 4; ++k) acc += cw[k] * xa_s[(t + k) * 64 + c];
        xc_s[t * 65 + c] = acc; }
    __syncthreads();
    { const int t = tid >> 3;
      float racc[8], iacc[8];
#pragma unroll
      for (int j = 0; j < 8; ++j) { racc[j] = 0.f; iacc[j] = 0.f; }
#pragma unroll 4
      for (int i = 0; i < 64; ++i) {
          const float x = xc_s[t * 65 + i];
          const f32x4 r0 = *(const LAS f32x4*)(wr_s + i * 64 + jg * 8), r1 = *(const LAS f32x4*)(wr_s + i * 64 + jg * 8 + 4);
          const f32x4 i0 = *(const LAS f32x4*)(wi_s + i * 64 + jg * 8), i1 = *(const LAS f32x4*)(wi_s + i * 64 + jg * 8 + 4);
#pragma unroll
          for (int j = 0; j < 4; ++j) { racc[j] += x * r0[j]; racc[4 + j] += x * r1[j]; iacc[j] += x * i0[j]; iacc[4 + j] += x * i1[j]; }
      }
#pragma unroll
      for (int jj = 0; jj < 8; ++jj) { const int j = jg * 8 + jj;
          const float brv = jj < 4 ? br0[jj & 3] : br1[jj & 3], biv = jj < 4 ? bi0[jj & 3] : bi1[jj & 3], lmv = jj < 4 ? lm0[jj & 3] : lm1[jj & 3];
          const float r = sigmoidf_(racc[jj] + brv), ig = sigmoidf_(iacc[jj] + biv);
          const float z = -lmv; const float sp = fmaxf(z, 0.f) + log1pf(__expf(-fabsf(z)));
          const float log_a = -8.0f * r * sp; const float av = __expf(log_a);
          const float uv = sqrtf(-expm1f(2.0f * log_a)) * (ig * xc_s[t * 65 + j]);
          a_s[t * 64 + j] = av; u_s[t * 64 + j] = uv; }
    }
    __syncthreads();
    {
        const int seg = tid >> 6; float hl[8], pl[8]; float H = 0.f, P = 1.f;
#pragma unroll
        for (int k = 0; k < 8; ++k) { const float av = a_s[(seg * 8 + k) * 64 + c]; H = av * H + u_s[(seg * 8 + k) * 64 + c]; P *= av; hl[k] = H; pl[k] = P; }
        sg_s[seg * 64 + c] = P; sg_s[512 + seg * 64 + c] = H;
        __syncthreads();
        float Hc = 0.f, Pc = 1.f;
#pragma unroll
        for (int s2 = 0; s2 < 7; ++s2) { const float ps = sg_s[s2 * 64 + c], hs = sg_s[512 + s2 * 64 + c]; if (s2 < seg) { Hc = ps * Hc + hs; Pc *= ps; } }
        float* HLOC = (float*)(a.ws + WS_HLOC); float* ACUM = (float*)(a.ws + WS_ACUM);
#pragma unroll
        for (int k = 0; k < 8; ++k) { const size_t idx = (size_t)(tokbase + t0 + seg * 8 + k) * WA + hd * 64 + c; HLOC[idx] = hl[k] + pl[k] * Hc; ACUM[idx] = pl[k] * Pc; }
        if (seg == 7) { ((float*)(a.ws + WS_AEND))[(size_t)bn * WA + hd * 64 + c] = pl[7] * Pc; ((float*)(a.ws + WS_HEND))[(size_t)bn * WA + hd * 64 + c] = hl[7] + pl[7] * Hc; }
    }
    __syncthreads();
}
struct GateRegs { u32x4 lrv; float wg0, wg1, bgv; };
__device__ __forceinline__ GateRegs gla_gate_issue(KArgs& a, int l, int tok0, int h, int tid) {
    GateRegs g; g.lrv = (u32x4){0u, 0u, 0u, 0u}; g.wg0 = 0.f; g.wg1 = 0.f; g.bgv = 0.f;
    const bf16_t* PROJ = (const bf16_t*)(a.ws + WS_R1);
    if (tid < 128) g.lrv = *(const u32x4*)(PROJ + (size_t)(tok0 + (tid >> 1)) * NINP + C_LR + (tid & 1) * 8);
    { const int r = tid / 48, d = tid % 48; g.wg0 = a.in[I_GLAWG][(size_t)(l * 16 + r) * 192 + h * 48 + d]; }
    if (tid < 256) { const int e = tid + 512, r = e / 48, d = e % 48; g.wg1 = a.in[I_GLAWG][(size_t)(l * 16 + r) * 192 + h * 48 + d]; }
    if (tid < 48) g.bgv = a.in[I_GLABG][(size_t)l * 192 + h * 48 + tid];
    return g;
}
__device__ __forceinline__ void gla_gate_finish(const GateRegs& g, int tid, LAS float* lr_s, LAS float* wg_s, LAS float* bg_s, LAS float* bc_s) {
    if (tid < 128) st8(lr_s + tid * 8, g.lrv);
    wg_s[tid] = g.wg0; if (tid < 256) wg_s[tid + 512] = g.wg1; if (tid < 48) bg_s[tid] = g.bgv;
    __syncthreads();
#pragma unroll
    for (int i = 0; i < 6; ++i) { const int e = tid + 512 * i, t = e / 48, d = e % 48; float acc = bg_s[d];
#pragma unroll
        for (int r = 0; r < 16; ++r) acc += lr_s[t * 16 + r] * wg_s[r * 48 + d];
        const float ls = fminf(acc, 0.f) - log1pf(__expf(-fabsf(acc)));
        bc_s[e] = ls * (1.0f / 16.0f); }
    __syncthreads();
    {
        const int seg = tid / 48, d = tid % 48; float loc[8]; float s = 0.f;
        if (tid < 384) {
#pragma unroll
            for (int k = 0; k < 8; ++k) { s += bc_s[(seg * 8 + k) * 48 + d]; loc[k] = s; }
            bg_s[64 + tid] = s; }
        __syncthreads();
        if (tid < 384) { float off = 0.f;
#pragma unroll
            for (int s2 = 0; s2 < 7; ++s2) { const float v = bg_s[64 + s2 * 48 + d]; if (s2 < seg) off += v; }
#pragma unroll
            for (int k = 0; k < 8; ++k) bc_s[(seg * 8 + k) * 48 + d] = loc[k] + off; }
    }
    __syncthreads();
}
__device__ __forceinline__ void gla1(KArgs& a, int l, int item, LAS float* L) {
    const int tid = otid();
    const int h = item & 3, bn = item >> 2, b = bn >> 5, n = bn & 31, tok0 = b * SEQ + n * 64;
    const bf16_t* PROJ = (const bf16_t*)(a.ws + WS_R1);
    LAS float* lr_s = L; LAS float* wg_s = L + 1024; LAS float* bg_s = L + 1792; LAS float* bc_s = L + 2240; LAS float* k_s = L + 5312; LAS float* v_s = L + 8384;
    const GateRegs g = gla_gate_issue(a, l, tok0, h, tid);
    const u32x4 z = {0u, 0u, 0u, 0u}; u32x4 kv = z, vv0 = z, vv1 = z;
    if (tid < 384) kv = *(const u32x4*)(PROJ + (size_t)(tok0 + tid / 6) * NINP + C_K + h * 48 + (tid % 6) * 8);
    vv0 = *(const u32x4*)(PROJ + (size_t)(tok0 + tid / 12) * NINP + C_V + h * 96 + (tid % 12) * 8);
    if (tid < 256) { const int e = tid + 512; vv1 = *(const u32x4*)(PROJ + (size_t)(tok0 + e / 12) * NINP + C_V + h * 96 + (e % 12) * 8); }
    if (tid < 384) st8(k_s + tid * 8, kv);
    st8(v_s + tid * 8, vv0); if (tid < 256) st8(v_s + (tid + 512) * 8, vv1);
    gla_gate_finish(g, tid, lr_s, wg_s, bg_s, bc_s);
#pragma unroll
    for (int i = 0; i < 6; ++i) { const int e = tid + 512 * i, d = e % 48; k_s[e] *= __expf(bc_s[63 * 48 + d] - bc_s[e]); }
    __syncthreads();
    { const int dg = tid >> 5, eg = tid & 31; float acc[3][3];
#pragma unroll
      for (int x = 0; x < 3; ++x)
#pragma unroll
          for (int y = 0; y < 3; ++y) acc[x][y] = 0.f;
#pragma unroll 8
      for (int t = 0; t < 64; ++t) { float kq[3], vq[3];
#pragma unroll
          for (int x = 0; x < 3; ++x) { kq[x] = k_s[t * 48 + dg + 16 * x]; vq[x] = v_s[t * 96 + eg + 32 * x]; }
#pragma unroll
          for (int x = 0; x < 3; ++x)
#pragma unroll
              for (int y = 0; y < 3; ++y) acc[x][y] += kq[x] * vq[y]; }
      float* U = (float*)(a.ws + WS_U) + (size_t)(bn * 4 + h) * 4608;
#pragma unroll
      for (int x = 0; x < 3; ++x)
#pragma unroll
          for (int y = 0; y < 3; ++y) U[(dg + 16 * x) * 96 + eg + 32 * y] = acc[x][y];
      if (tid < 48) ((float*)(a.ws + WS_DEC))[(size_t)(bn * 4 + h) * 48 + tid] = __expf(bc_s[63 * 48 + tid]);
    }
    __syncthreads();
}
__device__ __forceinline__ void conv_item(KArgs& a, int l, int item, LAS float* L) {
    const int tid = otid();
    const int b = item >> 6, ck = item & 63, t0 = ck * 32, tokbase = b * SEQ;
    const bf16_t* PROJ = (const bf16_t*)(a.ws + WS_R1);
    bf16_t* CAT = (bf16_t*)(a.ws + WS_CAT);
    {
        const u32x4 z = {0u, 0u, 0u, 0u}; u32x4 av[4], gv[4];
#pragma unroll
        for (int i = 0; i < 4; ++i) { const int e = tid + 512 * i, r = e >> 5, v = e & 31, s = t0 - 30 + r; av[i] = z; gv[i] = z;
            if (e < 62 * 32 && s >= 0) { const bf16_t* p = PROJ + (size_t)(tokbase + s) * NINP + v * 8; av[i] = *(const u32x4*)(p + C_CA); gv[i] = *(const u32x4*)(p + C_CG); } }
#pragma unroll
        for (int i = 0; i < 4; ++i) { const int e = tid + 512 * i;
            if (e < 62 * 32) { f32x4 al, ah, gl, gh; unpack8(av[i], al, ah); unpack8(gv[i], gl, gh);
#pragma unroll
                for (int j = 0; j < 4; ++j) { al[j] *= sigmoidf_(gl[j]); ah[j] *= sigmoidf_(gh[j]); }
                *(LAS f32x4*)(L + e * 8) = al; *(LAS f32x4*)(L + e * 8 + 4) = ah; } }
    }
    const int c = tid & 255, half = tid >> 8;
    float w[31];
#pragma unroll
    for (int k = 0; k < 31; ++k) w[k] = a.in[I_CVW][(size_t)(l * 31 + k) * WCV + c];
    const float bias = a.in[I_CVB][(size_t)l * WCV + c], gg = a.in[I_CVGG][(size_t)l * WCV + c], gb = a.in[I_CVGB][(size_t)l * WCV + c];
    __syncthreads();
    for (int tq = 0; tq < 4; ++tq) { const int t = half * 16 + tq * 4; float u[4] = {bias, bias, bias, bias};
#pragma unroll
        for (int r = 0; r < 34; ++r) { const float x = L[(t + r) * 256 + c];
#pragma unroll
            for (int q = 0; q < 4; ++q) { if (r - q >= 0 && r - q < 31) u[q] += w[r - q] * x; } }
        float mean[4], dv[4], var[4];
#pragma unroll
        for (int q = 0; q < 4; ++q) mean[q] = u[q];
#pragma unroll
        for (int o = 1; o < 64; o <<= 1) {
#pragma unroll
            for (int q = 0; q < 4; ++q) mean[q] += __shfl_xor(mean[q], o); }
#pragma unroll
        for (int q = 0; q < 4; ++q) { dv[q] = u[q] - mean[q] * (1.f / 64.f); var[q] = dv[q] * dv[q]; }
#pragma unroll
        for (int o = 1; o < 64; o <<= 1) {
#pragma unroll
            for (int q = 0; q < 4; ++q) var[q] += __shfl_xor(var[q], o); }
#pragma unroll
        for (int q = 0; q < 4; ++q) { const float un = dv[q] * (1.0f / sqrtf(var[q] * (1.f / 64.f) + EPS)) * gg + gb;
            CAT[(size_t)(tokbase + t0 + t + q) * D + 768 + c] = (bf16_t)f2bf(siluf_(un)); }
    }
    __syncthreads();
}
__device__ __forceinline__ void mixer2(KArgs& a) {
    const int g = blockIdx.x * NTHREADS + otid(), NT = gridDim.x * NTHREADS;
    { const float* AEND = (const float*)(a.ws + WS_AEND); const float* HEND = (const float*)(a.ws + WS_HEND); float* CIN = (float*)(a.ws + WS_CIN);
      for (int idx = g; idx < NB * WA; idx += NT) { const int b = idx / WA, c = idx % WA; float ae[32], he[32];
#pragma unroll
          for (int n = 0; n < 32; ++n) { ae[n] = AEND[(size_t)(b * 32 + n) * WA + c]; he[n] = HEND[(size_t)(b * 32 + n) * WA + c]; }
          float H = 0.f;
#pragma unroll
          for (int n = 0; n < 32; ++n) { CIN[(size_t)(b * 32 + n) * WA + c] = H; H = ae[n] * H + he[n]; } } }
    { float* U = (float*)(a.ws + WS_U); const float* DEC = (const float*)(a.ws + WS_DEC);
      for (int idx = g; idx < 32 * 4608; idx += NT) { const int bh = idx / 4608, de = idx % 4608, d = de / 96, b = bh >> 2, h = bh & 3; float uv[32], dc[32];
#pragma unroll
          for (int n = 0; n < 32; ++n) { uv[n] = U[(size_t)((b * 32 + n) * 4 + h) * 4608 + de]; dc[n] = DEC[(size_t)((b * 32 + n) * 4 + h) * 48 + d]; }
          float S = 0.f;
#pragma unroll
          for (int n = 0; n < 32; ++n) { U[(size_t)((b * 32 + n) * 4 + h) * 4608 + de] = S; S = dc[n] * S + uv[n]; } } }
}
__device__ __forceinline__ void rg_final(KArgs& a) {
    const int g = blockIdx.x * NTHREADS + otid(), NT = gridDim.x * NTHREADS;
    const f32x4* HLOC = (const f32x4*)(a.ws + WS_HLOC); const f32x4* ACUM = (const f32x4*)(a.ws + WS_ACUM); const f32x4* CIN = (const f32x4*)(a.ws + WS_CIN);
    const bf16_t* PROJ = (const bf16_t*)(a.ws + WS_R1); bf16_t* CAT = (bf16_t*)(a.ws + WS_CAT);
    constexpr int NV = MTOK * (WA / 4);
    for (int e0 = g; e0 < NV; e0 += 4 * NT) {
        f32x4 hv[4], av[4], cv[4]; u32x2 yv[4];
#pragma unroll
        for (int i = 0; i < 4; ++i) { const int e = e0 + i * NT; if (e < NV) { const int t = e / 96, c4 = e % 96;
            hv[i] = HLOC[e]; av[i] = ACUM[e]; cv[i] = CIN[(t >> 6) * 96 + c4]; yv[i] = *(const u32x2*)(PROJ + (size_t)t * NINP + C_YA + c4 * 4); } }
#pragma unroll
        for (int i = 0; i < 4; ++i) { const int e = e0 + i * NT; if (e < NV) { const int t = e / 96, c4 = e % 96;
            const f32x4 h = hv[i] + av[i] * cv[i];
            const float y0 = __uint_as_float(yv[i].x << 16), y1 = __uint_as_float(yv[i].x & 0xffff0000u), y2 = __uint_as_float(yv[i].y << 16), y3 = __uint_as_float(yv[i].y & 0xffff0000u);
            u32x2 o; o.x = pk2(h[0] * gelu_tanh(y0), h[1] * gelu_tanh(y1)); o.y = pk2(h[2] * gelu_tanh(y2), h[3] * gelu_tanh(y3));
            *(u32x2*)(CAT + (size_t)t * D + c4 * 4) = o; } }
    }
}
__device__ __forceinline__ void gla3(KArgs& a, int l, int item, LAS float* L) {
    const int tid = otid();
    const int h = item & 3, bn = item >> 2, b = bn >> 5, n = bn & 31, tok0 = b * SEQ + n * 64;
    const bf16_t* PROJ = (const bf16_t*)(a.ws + WS_R1); bf16_t* CAT = (bf16_t*)(a.ws + WS_CAT);
    LAS float* lr_s = L; LAS float* wg_s = L + 1024; LAS float* bg_s = L + 1792; LAS float* bc_s = L + 2240; LAS float* q_s = L + 5312; LAS float* k_s = L + 8640;
    LAS float* v_s = L + 11968; LAS float* sp_s = L + 18112; LAS float* sc_s = L + 22720;
    const GateRegs g = gla_gate_issue(a, l, tok0, h, tid);
    {
        const u32x4 z = {0u, 0u, 0u, 0u}; u32x4 qv = z, kv = z, vv0 = z, vv1 = z; const f32x4 zf = {0.f, 0.f, 0.f, 0.f}; f32x4 s0, s1, s2 = zf;
        if (tid < 384) { const bf16_t* p = PROJ + (size_t)(tok0 + tid / 6) * NINP + h * 48 + (tid % 6) * 8; qv = *(const u32x4*)(p + C_Q); kv = *(const u32x4*)(p + C_K); }
        vv0 = *(const u32x4*)(PROJ + (size_t)(tok0 + tid / 12) * NINP + C_V + h * 96 + (tid % 12) * 8);
        if (tid < 256) { const int e = tid + 512; vv1 = *(const u32x4*)(PROJ + (size_t)(tok0 + e / 12) * NINP + C_V + h * 96 + (e % 12) * 8); }
        const f32x4* U4 = (const f32x4*)((const float*)(a.ws + WS_U) + (size_t)(bn * 4 + h) * 4608);
        s0 = U4[tid]; s1 = U4[tid + 512]; if (tid < 128) s2 = U4[tid + 1024];
        if (tid < 384) { st8(q_s + (tid / 6) * 52 + (tid % 6) * 8, qv); st8(k_s + (tid / 6) * 52 + (tid % 6) * 8, kv); }
        st8(v_s + tid * 8, vv0); if (tid < 256) st8(v_s + (tid + 512) * 8, vv1);
        *(LAS f32x4*)(sp_s + tid * 4) = s0; *(LAS f32x4*)(sp_s + (tid + 512) * 4) = s1; if (tid < 128) *(LAS f32x4*)(sp_s + (tid + 1024) * 4) = s2;
    }
    gla_gate_finish(g, tid, lr_s, wg_s, bg_s, bc_s);
#pragma unroll
    for (int i = 0; i < 6; ++i) { const int e = tid + 512 * i, t = e / 48, d = e % 48; const float bc = bc_s[e];
        q_s[t * 52 + d] *= 0.14433756729740643f * __expf(bc); k_s[t * 52 + d] *= __expf(-bc); }
    __syncthreads();
    { const int ig = tid >> 4, jg = tid & 15; float acc[2][4];
#pragma unroll
      for (int x = 0; x < 2; ++x)
#pragma unroll
          for (int y = 0; y < 4; ++y) acc[x][y] = 0.f;
#pragma unroll 3
      for (int d4 = 0; d4 < 12; ++d4) {
          f32x4 qv[2], kv[4];
#pragma unroll
          for (int x = 0; x < 2; ++x) qv[x] = *(const LAS f32x4*)(q_s + (ig + 32 * x) * 52 + 4 * d4);
#pragma unroll
          for (int y = 0; y < 4; ++y) kv[y] = *(const LAS f32x4*)(k_s + (jg + 16 * y) * 52 + 4 * d4);
#pragma unroll
          for (int x = 0; x < 2; ++x)
#pragma unroll
              for (int y = 0; y < 4; ++y) acc[x][y] += (qv[x][0] * kv[y][0] + qv[x][1] * kv[y][1]) + (qv[x][2] * kv[y][2] + qv[x][3] * kv[y][3]);
      }
#pragma unroll
      for (int x = 0; x < 2; ++x)
#pragma unroll
          for (int y = 0; y < 4; ++y) { const int i = ig + 32 * x, j = jg + 16 * y; sc_s[i * 68 + j] = (j <= i) ? acc[x][y] : 0.f; }
    }
    __syncthreads();
    { const int ig = tid >> 5, eg = tid & 31; float acc[4][3];
      float gate[4][3];
#pragma unroll
      for (int x = 0; x < 4; ++x)
#pragma unroll
          for (int y = 0; y < 3; ++y) { acc[x][y] = 0.f; gate[x][y] = bf2f(PROJ[(size_t)(tok0 + ig + 16 * x) * NINP + C_G + h * 96 + eg + 32 * y]); }
#pragma unroll 2
      for (int j4 = 0; j4 < 16; ++j4) {
          f32x4 s4[4];
#pragma unroll
          for (int x = 0; x < 4; ++x) s4[x] = *(const LAS f32x4*)(sc_s + (ig + 16 * x) * 68 + 4 * j4);
#pragma unroll
          for (int jj = 0; jj < 4; ++jj) { float vv[3];
#pragma unroll
              for (int y = 0; y < 3; ++y) vv[y] = v_s[(4 * j4 + jj) * 96 + eg + 32 * y];
#pragma unroll
              for (int x = 0; x < 4; ++x)
#pragma unroll
                  for (int y = 0; y < 3; ++y) acc[x][y] += s4[x][jj] * vv[y]; }
      }
#pragma unroll 2
      for (int d4 = 0; d4 < 12; ++d4) {
          f32x4 q4[4];
#pragma unroll
          for (int x = 0; x < 4; ++x) q4[x] = *(const LAS f32x4*)(q_s + (ig + 16 * x) * 52 + 4 * d4);
#pragma unroll
          for (int dd = 0; dd < 4; ++dd) { float sv[3];
#pragma unroll
              for (int y = 0; y < 3; ++y) sv[y] = sp_s[(4 * d4 + dd) * 96 + eg + 32 * y];
#pragma unroll
              for (int x = 0; x < 4; ++x)
#pragma unroll
                  for (int y = 0; y < 3; ++y) acc[x][y] += q4[x][dd] * sv[y]; }
      }
      const float* ng = a.in[I_GLANG] + (size_t)l * 96;
      float ngv[3];
#pragma unroll
      for (int y = 0; y < 3; ++y) ngv[y] = ng[eg + 32 * y];
#pragma unroll
      for (int x = 0; x < 4; ++x) { const int i = ig + 16 * x;
          float ss = acc[x][0] * acc[x][0] + acc[x][1] * acc[x][1] + acc[x][2] * acc[x][2];
#pragma unroll
          for (int o = 1; o < 32; o <<= 1) ss += __shfl_xor(ss, o);
          const float r = 1.0f / sqrtf(ss * (1.f / 96.f) + EPS);
#pragma unroll
          for (int y = 0; y < 3; ++y) { const int e = eg + 32 * y;
              CAT[(size_t)(tok0 + i) * D + WA + h * 96 + e] = (bf16_t)f2bf(acc[x][y] * r * ngv[y] * siluf_(gate[x][y])); } }
    }
    __syncthreads();
}

#define PROBE_MASK 0
constexpr int PH_PER_LAYER = 17, N_PHASES = 1 + DEPTH * PH_PER_LAYER;

__device__ __forceinline__ void run_phase(KArgs& a, int p, LAS unsigned char* lds) {
    unsigned char* ws = a.ws;
    const int G = gridDim.x, bx = blockIdx.x;
    bf16_t* XN = (bf16_t*)(ws + WS_XN); float* Y = (float*)(ws + WS_Y); float* STATS = (float*)(ws + WS_STATS);
    if (p == 0) {
        convert_weights(a, 0, lds);
        cvt_rows(a.in[I_X], XN, (size_t)MTOK * D);
        cvt_rows(a.in[I_MEM], (bf16_t*)(ws + WS_MEMB), (size_t)MMEM * D);
        return;
    }
    const int l = (p - 1) / PH_PER_LAYER, s = (p - 1) % PH_PER_LAYER;
#ifdef TEST_ONLY
    if (s != TEST_ONLY) return;
#endif
    switch (s) {
    case 0: case 14: {
        StdProb S; S.init(XN, (const bf16_t*)(ws + (s == 0 ? WS_W1T_A : WS_W1T_B)), D, D, D, MTOK, 2 * FF, G, bx);
        EpiSwiGLU E{(bf16_t*)(ws + WS_R1)};
        gemm_phase(lds, S, E);
    } break;
    case 1: case 7: case 12: case 15: {
        const bf16_t* A; const bf16_t* Bt; int K; const float* g; const float* b; float scale; const float* Xin = nullptr;
        if (s == 1) { A = (const bf16_t*)(ws + WS_R1); Bt = (const bf16_t*)(ws + WS_W2T_A); K = FF; scale = 0.5f;
            if (l == 0) { Xin = a.in[I_X]; g = a.in[I_LN4G]; b = a.in[I_LN4B]; } else { g = a.in[I_LN4G] + (size_t)(l - 1) * D; b = a.in[I_LN4B] + (size_t)(l - 1) * D; } }
        else if (s == 7) { A = (const bf16_t*)(ws + WS_CAT); Bt = (const bf16_t*)(ws + WS_WOUTT); K = D; scale = 1.0f; g = a.in[I_LN1G] + (size_t)l * D; b = a.in[I_LN1B] + (size_t)l * D; }
        else if (s == 12) { A = (const bf16_t*)(ws + WS_CAT); Bt = (const bf16_t*)(ws + WS_WOT); K = D; scale = 1.0f; g = a.in[I_LN2G] + (size_t)l * D; b = a.in[I_LN2B] + (size_t)l * D; }
        else { A = (const bf16_t*)(ws + WS_R1); Bt = (const bf16_t*)(ws + WS_W2T_B); K = FF; scale = 0.5f; g = a.in[I_LN3G] + (size_t)l * D; b = a.in[I_LN3B] + (size_t)l * D; }
        StdProb S; S.init(A, Bt, K, K, K, MTOK, D, G, bx);
        EpiRes E{Y, Xin, STATS, g, b, scale};
        gemm_phase(lds, S, E);
    } break;
    case 2: case 8: case 13: case 16: {
        const float* gp = s == 2 ? a.in[I_LN1G] : s == 8 ? a.in[I_LN2G] : s == 13 ? a.in[I_LN3G] : a.in[I_LN4G];
        const float* bp = s == 2 ? a.in[I_LN1B] : s == 8 ? a.in[I_LN2B] : s == 13 ? a.in[I_LN3B] : a.in[I_LN4B];
        const bool fin = (s == 16 && l == DEPTH - 1);
        ln_phase(Y, gp + (size_t)l * D, bp + (size_t)l * D, XN, STATS, fin ? a.out : nullptr);
        if (s == 16 && l + 1 < DEPTH) convert_weights(a, l + 1, lds);
    } break;
    case 3: {
        { StdProb S; S.init(XN, (const bf16_t*)(ws + WS_WINT), D, D, D, MTOK, NINP, G, bx);
          EpiBf16 E{(bf16_t*)(ws + WS_R1), NINP, 1.0f}; gemm_phase(lds, S, E); }
        { StdProb S; S.init((const bf16_t*)(ws + WS_MEMB), (const bf16_t*)(ws + WS_WKVT), D, D, D, MMEM, D, G, (bx + G - (G / 2)) % G);
          EpiBf16 E{(bf16_t*)(ws + WS_KM), D, 1.0f}; gemm_phase(lds, S, E); }
        { StdProb S; S.init((const bf16_t*)(ws + WS_WKVT) + (size_t)D * D, (const bf16_t*)(ws + WS_MEMB), D, D, D, D, MMEM, G, (bx + G - (G / 2 + 32)) % G);
          EpiBf16 E{(bf16_t*)(ws + WS_VT), MMEM, 1.0f}; gemm_phase(lds, S, E); }
    } break;
    case 4: {
        LAS float* L = (LAS float*)lds;
        for (int it = bx; it < 3072; it += G) { if (it < 1536) rg_local(a, l, it, L); else if (it < 2560) gla1(a, l, it - 1536, L); else conv_item(a, l, it - 2560, L); }
    } break;
    case 5: mixer2(a); break;
    case 6: {
        LAS float* L = (LAS float*)lds;
        rg_final(a);
        for (int it = bx; it < 1024; it += G) gla3(a, l, it, L);
    } break;
    case 9: {
        StdProb S; S.init(XN, (const bf16_t*)(ws + WS_WQT), D, D, D, MTOK, D, G, bx);
        EpiBf16 E{(bf16_t*)(ws + WS_R1), D, 0.0625f}; gemm_phase(lds, S, E);
    } break;
    case 10: {
        ScoreProb S{(const bf16_t*)(ws + WS_R1), (const bf16_t*)(ws + WS_KM), D, D, 256, G, bx};
        EpiExp E{(bf16_t*)(ws + WS_R1 + R1_P_OFF), (float*)(ws + WS_PSUM)}; gemm_phase(lds, S, E);
    } break;
    case 11: {
        PVProb S{(const bf16_t*)(ws + WS_R1 + R1_P_OFF), (const bf16_t*)(ws + WS_VT), 256, MMEM, 256, G, bx};
        EpiPV E{(bf16_t*)(ws + WS_CAT), (const float*)(ws + WS_PSUM)}; gemm_phase(lds, S, E);
    } break;
    default: break;
    }
}

__global__ void __launch_bounds__(NTHREADS, 2) fwd_megakernel(Args args) {
    extern __shared__ __attribute__((aligned(16))) unsigned char lds_raw[];
    LAS unsigned char* lds = (LAS unsigned char*)lds_raw;
    cg::grid_group grid = cg::this_grid();
    volatile LAS unsigned* st = (volatile LAS unsigned*)(lds + 131072 + 4096);
    if (threadIdx.x < 2) st[threadIdx.x] = 0u;
    unsigned* barw = (unsigned*)(args.ws + WS_BAR);
    if (blockIdx.x == 0) for (int i = threadIdx.x; i < XCD_BAR_WORDS; i += NTHREADS) barw[i] = 0u;
    __syncthreads();
    XcdBarrier xb; xb.bar = barw; xb.x = 0; xb.st = st;
    const int ph_lo = args.ph_lo, ph_hi = args.ph_hi;
    for (int p = ph_lo; p < ph_hi; ++p) {
        KArgs* ap = (KArgs*)__builtin_amdgcn_kernarg_segment_ptr();
        asm volatile("" : "+s"(ap));
        run_phase(*ap, p, lds);
#if PROBE_MASK
        { const int s_ = p > 0 ? (p - 1) % PH_PER_LAYER : -1;
          if (s_ >= 0 && ((PROBE_MASK >> s_) & 1)) { __syncthreads(); run_phase(*ap, p, lds); } }
#endif
        if (p + 1 < ph_hi) {
            if (p == ph_lo) { grid.sync(); xb = xcd_barrier_post(barw, st); }
            else xcd_barrier(xb);
        }
    }
}

extern "C" void kernel_launch(void* const* d_in, const int* in_sizes, int n_in, void* d_out, int out_size, void* d_ws, size_t ws_size, hipStream_t stream) {
    static int grid = 0;
    if (grid == 0) {
        if (n_in != 33 || ws_size < WS_END) { fprintf(stderr, "kernel_launch: unexpected n_in %d or ws_size %zu (need %zu)\n", n_in, ws_size, (size_t)WS_END); grid = -1; return; }
        int dev = 0, cus = 0, per_cu = 0;
        (void)hipGetDevice(&dev);
        (void)hipDeviceGetAttribute(&cus, hipDeviceAttributeMultiprocessorCount, dev);
        if (hipFuncSetAttribute((const void*)fwd_megakernel, hipFuncAttributeMaxDynamicSharedMemorySize, LDS_BYTES) != hipSuccess) { fprintf(stderr, "kernel_launch: hipFuncSetAttribute failed\n"); grid = -1; return; }
        if (hipOccupancyMaxActiveBlocksPerMultiprocessor(&per_cu, (const void*)fwd_megakernel, NTHREADS, LDS_BYTES) != hipSuccess || per_cu < 1) { fprintf(stderr, "kernel_launch: occupancy query says %d\n", per_cu); per_cu = 1; }
        (void)hipGetLastError();
        grid = cus > 0 ? cus : 256;
    }
    if (grid < 0) return;
    Args a{};
    for (int i = 0; i < 33; ++i) a.in[i] = (const float*)d_in[i];
    a.out = (float*)d_out; a.ws = (unsigned char*)d_ws; a.ph_lo = 0; a.ph_hi = N_PHASES;
    void* kargs[] = {&a};
    hipError_t e = hipLaunchCooperativeKernel((const void*)fwd_megakernel, dim3(grid), dim3(NTHREADS), kargs, LDS_BYTES, stream);
    if (e != hipSuccess) fprintf(stderr, "cooperative launch failed: %s (grid %d)\n", hipGetErrorString(e), grid);
}
```
